# Optimizing an MI355X kernel written in HIP

```python
import jax
import jax.numpy as jnp
from jax import lax
import numpy as np

D_MODEL = 1024
BATCH = 4
SEQ = 8192
DEPTH = 4

CHUNK = 64
PLE_DIM = 256
D_FF = 2816
RW_HEADS = 8
RW_HEAD_DIM = 64
RW_WIDTH = RW_HEADS * RW_HEAD_DIM
RW_CHUNK = CHUNK
RW_DECAY_LORA = 64
RW_AAA_LORA = 64
RW_GATE_LORA = 160
RW_GN_EPS = 64e-5
SB_HEADS = 4
SB_HEAD_DIM = 128
SB_WIDTH = SB_HEADS * SB_HEAD_DIM
SB_BLOCK = 128
HG_HEADS = 4
HG_EXPAND = 128
HG_HEAD_V = 128
HG_FWIDTH = HG_HEADS * HG_EXPAND
HG_VWIDTH = HG_HEADS * HG_HEAD_V
HG_CHUNK = 16
HG_EPS = 1e-5
N_BRANCH = 3
LN_EPS = 1e-5
ALPHA = (2 * DEPTH) ** 0.25
BETA = (8 * DEPTH) ** -0.25

RW_SPLITS = [RW_WIDTH, RW_WIDTH, RW_WIDTH, RW_DECAY_LORA, RW_AAA_LORA, RW_GATE_LORA]
RW_COLS = sum(RW_SPLITS)
SB_COLS = 3 * SB_WIDTH
HG_SPLITS = [HG_FWIDTH, HG_FWIDTH, HG_VWIDTH, HG_VWIDTH]
HG_COLS = sum(HG_SPLITS)
GATE_COLS = N_BRANCH * D_MODEL
IN_SPLITS = [RW_COLS, SB_COLS, HG_COLS, GATE_COLS]
IN_COLS = sum(IN_SPLITS)

kernel_name = "hybrid_rwkv7_stickbreak_hgrn2_macaron_deepnorm"


def split_cols(u, sizes):
    idx = np.cumsum(sizes)[:-1].tolist()
    return jnp.split(u, idx, axis=-1)


def heads(t, n_heads):
    b, s, c = t.shape
    return t.reshape(b, s, n_heads, c // n_heads)


def layer_norm(x, g, b):
    xf = x.astype(jnp.float32)
    mu = jnp.mean(xf, axis=-1, keepdims=True)
    var = jnp.mean(jnp.square(xf - mu), axis=-1, keepdims=True)
    return ((xf - mu) * lax.rsqrt(var + LN_EPS) * g + b).astype(x.dtype)


def head_norm(y, g, b, eps):
    mu = jnp.mean(y, axis=-1, keepdims=True)
    var = jnp.mean(jnp.square(y - mu), axis=-1, keepdims=True)
    y = ((y - mu) * lax.rsqrt(var + eps)).reshape(y.shape[:2] + (-1,))
    return y * g + b


def head_rms_norm(y, g, eps):
    y = y * lax.rsqrt(jnp.mean(jnp.square(y), axis=-1, keepdims=True) + eps)
    return y.reshape(y.shape[:2] + (-1,)) * g


def swiglu(h, wg, wu, wd):
    return (jax.nn.silu(h @ wg) * (h @ wu)) @ wd


def token_shift(u):
    return jnp.pad(u[:, :-1], ((0, 0), (1, 0), (0, 0)))


def rwkv7_chunked(r, log_w, k, v, a, b):
    bsz, seq, nh, n = r.shape
    nc = seq // RW_CHUNK
    f32 = jnp.float32

    def chunks(t):
        return t.astype(f32).reshape(bsz, nc, RW_CHUNK, nh, n).transpose(0, 1, 3, 2, 4)

    r, log_w, k, v, a, b = (chunks(t) for t in (r, log_w, k, v, a, b))
    g = jnp.cumsum(log_w, axis=3)
    g_last = g[..., -1:, :]
    inv = jnp.exp(-g)
    a_dec = a * jnp.exp(g - log_w)
    r_dec = r * jnp.exp(g)
    b_inv = b * inv
    k_inv = k * inv
    strict = jnp.tril(jnp.ones((RW_CHUNK, RW_CHUNK), bool), -1)
    incl = jnp.tril(jnp.ones((RW_CHUNK, RW_CHUNK), bool))

    def pair(x_t, y_s, mask):
        return jnp.where(mask, jnp.einsum('bnhtk,bnhsk->bnhts', x_t, y_s), 0.0)

    L_ab = pair(a_dec, b_inv, strict)
    L_ak = pair(a_dec, k_inv, strict)
    M_rb = pair(r_dec, b_inv, incl)
    M_rk = pair(r_dec, k_inv, incl)
    lhs = jnp.eye(RW_CHUNK, dtype=f32) - L_ab
    W1 = lax.linalg.triangular_solve(lhs, a_dec, left_side=True, lower=True, unit_diagonal=True)
    U0 = lax.linalg.triangular_solve(lhs, jnp.einsum('bnhts,bnhsv->bnhtv', L_ak, v),
                                     left_side=True, lower=True, unit_diagonal=True)
    Q_eff = r_dec + jnp.einsum('bnhts,bnhsk->bnhtk', M_rb, W1)
    Y_intra = jnp.einsum('bnhts,bnhsv->bnhtv', M_rb, U0) + jnp.einsum('bnhts,bnhsv->bnhtv', M_rk, v)
    dec = jnp.exp(g_last - g)
    b_dec = b * dec
    k_dec = k * dec
    P = jnp.einsum('bnhck,bnhcj->bnhkj', W1, b_dec) + jnp.exp(g_last)[..., 0, :, None] * jnp.eye(n, dtype=f32)
    D = jnp.einsum('bnhcv,bnhcj->bnhvj', U0, b_dec) + jnp.einsum('bnhcv,bnhcj->bnhvj', v, k_dec)

    def step(S, inp):
        P_c, D_c = inp
        return jnp.einsum('bhvk,bhkj->bhvj', S, P_c) + D_c, S

    S0 = jnp.zeros((bsz, nh, n, n), f32)
    _, S_in = lax.scan(step, S0, (jnp.moveaxis(P, 1, 0), jnp.moveaxis(D, 1, 0)))
    S_in = jnp.moveaxis(S_in, 0, 1)
    y = Y_intra + jnp.einsum('bnhck,bnhvk->bnhcv', Q_eff, S_in)
    return y.transpose(0, 1, 3, 2, 4).reshape(bsz, seq, nh, n)


def rwkv7_mix(u, mu, w0, w_up, a0, a_up, g_up, k_k, k_a, r_k, gn_g, gn_b):
    f32 = jnp.float32
    u = u + (token_shift(u) - u) * mu
    r, k, v, xw, xa, xg = split_cols(u, RW_SPLITS)
    w_log = -jax.nn.softplus(-(w0 + jnp.tanh(xw) @ w_up)) - 0.5
    log_w = -jnp.exp(w_log.astype(f32))
    a = jax.nn.sigmoid(a0 + xa @ a_up)
    g = jax.nn.sigmoid(xg) @ g_up
    kk = heads(k * k_k, RW_HEADS).astype(f32)
    kk = kk / jnp.maximum(jnp.linalg.norm(kk, axis=-1, keepdims=True), 1e-12)
    k = k * (1 + (a - 1) * k_a)
    r_h, k_h, v_h, a_h = (heads(t, RW_HEADS) for t in (r, k, v, a))
    y = rwkv7_chunked(r_h, heads(log_w, RW_HEADS), k_h, v_h, -kk, kk * a_h.astype(f32))
    y = head_norm(y, gn_g, gn_b, RW_GN_EPS)
    bonus = (jnp.sum(r_h * k_h * r_k, axis=-1, keepdims=True) * v_h).reshape(y.shape)
    return ((y + bonus) * g).astype(u.dtype)


def stick_breaking_attention(q, k, v):
    bsz, seq, nh, hd = q.shape
    f32 = jnp.float32
    qf = (q.astype(f32) * (hd ** -0.5)).transpose(0, 2, 1, 3)
    kf = k.astype(f32).transpose(0, 2, 1, 3)
    vf = v.astype(f32).transpose(0, 2, 1, 3)
    incl_upper = jnp.triu(jnp.ones((SB_BLOCK, SB_BLOCK), f32))
    diag_mask = jnp.tril(jnp.ones((SB_BLOCK, SB_BLOCK), bool), -1)
    outs = []
    for i in range(seq // SB_BLOCK):
        nk = i + 1
        lk = nk * SB_BLOCK
        qb = qf[:, :, i * SB_BLOCK:lk]
        z = jnp.einsum('bhqd,bhkd->bhqk', qb, kf[:, :, :lk]).reshape(bsz, nh, SB_BLOCK, nk, SB_BLOCK)
        mask = jnp.concatenate([jnp.ones((SB_BLOCK, i, SB_BLOCK), bool), diag_mask[:, None, :]], axis=1)
        m = jnp.where(mask, -jax.nn.softplus(z), 0.0)
        within = jnp.einsum('bhqnj,ij->bhqni', m, incl_upper)
        later = jnp.triu(jnp.ones((nk, nk), f32), 1)
        carry = jnp.einsum('bhqm,nm->bhqn', jnp.sum(m, axis=-1), later)
        att = jnp.where(mask, jnp.exp(z + within + carry[..., None]), 0.0)
        vb = vf[:, :, :lk].reshape(bsz, nh, nk, SB_BLOCK, hd)
        outs.append(jnp.einsum('bhqnk,bhnkd->bqhd', att, vb))
    return jnp.concatenate(outs, axis=1).reshape(bsz, seq, nh * hd).astype(q.dtype)


def hgrn2_mix(q_raw, f_raw, i_val, out_gate, lb, norm_g):
    bsz, seq, _ = q_raw.shape
    nc = seq // HG_CHUNK
    f32 = jnp.float32
    q = jax.nn.sigmoid(q_raw.astype(f32))
    log_f = jnp.logaddexp(jnp.log(lb), jnp.log1p(-lb) + jax.nn.log_sigmoid(f_raw.astype(f32)))
    k = -jnp.expm1(log_f)

    def chunks(t, hd):
        return t.reshape(bsz, nc, HG_CHUNK, HG_HEADS, hd).transpose(0, 1, 3, 2, 4)

    q, k, g = chunks(q, HG_EXPAND), chunks(k, HG_EXPAND), chunks(log_f, HG_EXPAND)
    v = chunks(i_val.astype(f32), HG_HEAD_V)
    G = jnp.cumsum(g, axis=3)
    causal = jnp.tril(jnp.ones((HG_CHUNK, HG_CHUNK), bool))[:, :, None]
    diff = jnp.where(causal, G[..., :, None, :] - G[..., None, :, :], -jnp.inf)
    att = jnp.sum(q[..., :, None, :] * jnp.exp(diff) * k[..., None, :, :], axis=-1)
    intra = jnp.einsum('bnhts,bnhsv->bnhtv', att, v)
    G_last = G[..., -1:, :]
    D = jnp.einsum('bnhsk,bnhsv->bnhkv', k * jnp.exp(G_last - G), v)
    gam = jnp.exp(G_last[..., 0, :])

    def step(S, inp):
        gam_c, D_c = inp
        return gam_c[..., None] * S + D_c, S

    S0 = jnp.zeros((bsz, HG_HEADS, HG_EXPAND, HG_HEAD_V), f32)
    _, S_in = lax.scan(step, S0, (jnp.moveaxis(gam, 1, 0), jnp.moveaxis(D, 1, 0)))
    S_in = jnp.moveaxis(S_in, 0, 1)
    inter = jnp.einsum('bnhtk,bnhkv->bnhtv', q * jnp.exp(G), S_in)
    o = (inter + intra).transpose(0, 1, 3, 2, 4).reshape(bsz, seq, HG_HEADS, HG_HEAD_V)
    o = head_rms_norm(o, norm_g, HG_EPS)
    return (o * jax.nn.silu(out_gate.astype(f32))).astype(q_raw.dtype)


def hybrid_mixer(h, w_in, rw_mu, rw_w0, rw_w_up, rw_a0, rw_a_up, rw_g_up, rw_k_k, rw_k_a,
                 rw_r_k, rw_gn_g, rw_gn_b, lb, hg_norm_g, w_br_rw, w_br_sb, w_br_hg, w_out):
    u_rw, u_sb, u_hg, u_gate = split_cols(h @ w_in, IN_SPLITS)
    y_rw = rwkv7_mix(u_rw, rw_mu, rw_w0, rw_w_up, rw_a0, rw_a_up, rw_g_up, rw_k_k, rw_k_a,
                     rw_r_k, rw_gn_g, rw_gn_b)
    q, k, v = (heads(t, SB_HEADS) for t in split_cols(u_sb, [SB_WIDTH] * 3))
    y_sb = stick_breaking_attention(q, k, v)
    hq, hf, hi, hg = split_cols(u_hg, HG_SPLITS)
    y_hg = hgrn2_mix(hq, hf, hi, hg, lb, hg_norm_g)
    g_rw, g_sb, g_hg = split_cols(jax.nn.sigmoid(u_gate), [D_MODEL] * N_BRANCH)
    merged = g_rw * (y_rw @ w_br_rw) + g_sb * (y_sb @ w_br_sb) + g_hg * (y_hg @ w_br_hg)
    return merged @ w_out


def setup_inputs(seed: int = 0) -> dict:
    key = jax.random.key(seed)
    ks = jax.random.split(key, 32)
    L = DEPTH
    D = D_MODEL

    def nrm(k, shape, scale):
        return jax.random.normal(k, shape, jnp.float32) * scale

    return {
        "x": nrm(ks[0], (BATCH, SEQ, D), 1.0),
        "p": nrm(ks[1], (L, BATCH, SEQ, PLE_DIM), 1.0),
        "ln_g": 1.0 + nrm(ks[2], (L, 4, D), 0.02),
        "ln_b": nrm(ks[3], (L, 4, D), 0.01),
        "ffn1_wg": nrm(ks[4], (L, D, D_FF), D ** -0.5),
        "ffn1_wu": nrm(ks[5], (L, D, D_FF), D ** -0.5),
        "ffn1_wd": nrm(ks[6], (L, D_FF, D), BETA * D_FF ** -0.5),
        "w_in": nrm(ks[7], (L, D, IN_COLS), D ** -0.5),
        "rw_mu": jax.random.uniform(ks[8], (L, RW_COLS), jnp.float32, 0.05, 0.95),
        "rw_w0": jax.random.uniform(ks[9], (L, RW_WIDTH), jnp.float32, -6.0, -1.0),
        "rw_w_up": nrm(ks[10], (L, RW_DECAY_LORA, RW_WIDTH), 0.1 * RW_DECAY_LORA ** -0.5),
        "rw_a0": nrm(ks[11], (L, RW_WIDTH), 0.1),
        "rw_a_up": nrm(ks[12], (L, RW_AAA_LORA, RW_WIDTH), 0.1 * RW_AAA_LORA ** -0.5),
        "rw_g_up": nrm(ks[13], (L, RW_GATE_LORA, RW_WIDTH), RW_GATE_LORA ** -0.5),
        "rw_k_k": 0.85 + nrm(ks[14], (L, RW_WIDTH), 0.05),
        "rw_k_a": 1.0 + nrm(ks[15], (L, RW_WIDTH), 0.05),
        "rw_r_k": nrm(ks[16], (L, RW_HEADS, RW_HEAD_DIM), 0.1),
        "rw_gn_g": 1.0 + nrm(ks[17], (L, RW_WIDTH), 0.02),
        "rw_gn_b": nrm(ks[18], (L, RW_WIDTH), 0.01),
        "hg_lb_raw": nrm(ks[19], (L, HG_FWIDTH), 0.1),
        "hg_norm_g": 1.0 + nrm(ks[20], (L, HG_VWIDTH), 0.02),
        "w_br_rw": nrm(ks[21], (L, RW_WIDTH, D), RW_WIDTH ** -0.5),
        "w_br_sb": nrm(ks[22], (L, SB_WIDTH, D), SB_WIDTH ** -0.5),
        "w_br_hg": nrm(ks[23], (L, HG_VWIDTH, D), HG_VWIDTH ** -0.5),
        "w_out": nrm(ks[24], (L, D, D), BETA * D ** -0.5),
        "ffn2_wg": nrm(ks[25], (L, D, D_FF), D ** -0.5),
        "ffn2_wu": nrm(ks[26], (L, D, D_FF), D ** -0.5),
        "ffn2_wd": nrm(ks[27], (L, D_FF, D), BETA * D_FF ** -0.5),
        "ple_gate": nrm(ks[28], (L, D, D), D ** -0.5),
        "ple_proj": nrm(ks[29], (L, PLE_DIM, D), BETA * PLE_DIM ** -0.5),
    }


def reference(x, p, ln_g, ln_b, ffn1_wg, ffn1_wu, ffn1_wd, w_in, rw_mu, rw_w0, rw_w_up, rw_a0,
              rw_a_up, rw_g_up, rw_k_k, rw_k_a, rw_r_k, rw_gn_g, rw_gn_b, hg_lb_raw, hg_norm_g,
              w_br_rw, w_br_sb, w_br_hg, w_out, ffn2_wg, ffn2_wu, ffn2_wd, ple_gate, ple_proj):
    lb_sm = jax.nn.softmax(hg_lb_raw.astype(jnp.float32), axis=0)
    lb_all = jnp.cumsum(lb_sm, axis=0)
    lb_all = lb_all - lb_all[0:1]
    h = x
    for i in range(DEPTH):
        h = layer_norm(ALPHA * h + 0.5 * swiglu(h, ffn1_wg[i], ffn1_wu[i], ffn1_wd[i]), ln_g[i, 0], ln_b[i, 0])
        mix = hybrid_mixer(h, w_in[i], rw_mu[i], rw_w0[i], rw_w_up[i], rw_a0[i], rw_a_up[i], rw_g_up[i],
                           rw_k_k[i], rw_k_a[i], rw_r_k[i], rw_gn_g[i], rw_gn_b[i], lb_all[i],
                           hg_norm_g[i], w_br_rw[i], w_br_sb[i], w_br_hg[i], w_out[i])
        h = layer_norm(ALPHA * h + mix, ln_g[i, 1], ln_b[i, 1])
        h = layer_norm(ALPHA * h + 0.5 * swiglu(h, ffn2_wg[i], ffn2_wu[i], ffn2_wd[i]), ln_g[i, 2], ln_b[i, 2])
        ple = jax.nn.sigmoid(h @ ple_gate[i]) * (p[i] @ ple_proj[i])
        h = layer_norm(ALPHA * h + ple, ln_g[i, 3], ln_b[i, 3])
    return h
```

```cpp
#include <hip/hip_runtime.h>
#include <hip/hip_bf16.h>
#include <hip/hip_cooperative_groups.h>
#include <cstdio>
namespace cg = cooperative_groups;

typedef __hip_bfloat16 bf16;
using bf16x8 = __attribute__((ext_vector_type(8))) short;
using f32x4 = __attribute__((ext_vector_type(4))) float;

#define MTOK 32768
#define DM 1024
#define DFF 2816
#define SEQ 8192
#define LDU 2048
#define MIB ((size_t)1 << 20)
#define ALPHA_F 1.681792830507429f

#define OFF_H32 ((size_t)0)
#define OFF_H16 (128 * MIB)
#define OFF_W (192 * MIB)
#define OFF_R (250 * MIB)
#define OFF_P16 (OFF_R + 128 * MIB)
#define OFF_ACT (OFF_R)
#define OFF_U (OFF_R)
#define OFF_YRW (OFF_R + 128 * MIB)
#define OFF_YSB (OFF_R + 160 * MIB)
#define OFF_YHG (OFF_R + 192 * MIB)
#define OFF_SCR (OFF_R + 224 * MIB)
#define OFF_RP (OFF_SCR)
#define OFF_RD (OFF_SCR + 64 * MIB)
#define OFF_RYI (OFF_SCR + 128 * MIB)
#define OFF_RQE (OFF_SCR + 160 * MIB)
#define OFF_RGT (OFF_SCR + 192 * MIB)
#define OFF_RBC (OFF_SCR + 224 * MIB)
#define OFF_HD (OFF_SCR)
#define OFF_HS (OFF_SCR + 128 * MIB)
#define OFF_HG (OFF_SCR + 192 * MIB)
#define OFF_GATE (OFF_R + 224 * MIB)
#define OFF_M32 (OFF_R)
#define W_F1GU 0
#define W_F1D 5767168
#define W_F2GU 8650752
#define W_F2D 14417920
#define W_RW 17301504
#define W_SB 19398656
#define W_HG 20971520
#define W_GATE 23068672
#define W_BR 26214400
#define W_OUT 27787264
#define W_PG 28835840
#define W_PP 29884416

#define LDS_BYTES 155648
#define GRID 256
#define PHASE_TID int tid = threadIdx.x; asm volatile("" : "+v"(tid)); int bid = blockIdx.x; asm volatile("" : "+s"(bid));

struct Params {
  const float* in[30];
  float* out;
  unsigned char* ws;
};

typedef const __attribute__((address_space(4))) Params* KP;
extern __shared__ __attribute__((aligned(16))) unsigned char smem_raw[];


#define OFF_BAR (249 * MIB + 768 * 1024)
#define OFF_STATS (249 * MIB + 512 * 1024)
#define XB_TMO      128
#define XB_XCNT(j)  (256  + 64 * (j))
#define XB_XSUB(j)  (1280 + 64 * (j))
#define XB_XGEN(j)  (2304 + 64 * (j))
#define XB_TOP      3328
#define XB_TOPGEN   3392
#define XCD_BAR_WORDS 3456
#define XB_SPIN_CAP (1u << 22)
#define XB_LDS_OFF (LDS_BYTES - 16)
__device__ __forceinline__ unsigned xb_ld(unsigned* p) { return __hip_atomic_load(p, __ATOMIC_RELAXED, __HIP_MEMORY_SCOPE_AGENT); }
__device__ __forceinline__ unsigned xb_add(unsigned* p, unsigned v) { return __hip_atomic_fetch_add(p, v, __ATOMIC_RELAXED, __HIP_MEMORY_SCOPE_AGENT); }
__device__ __forceinline__ unsigned xb_xcc_id() { return (unsigned)__builtin_amdgcn_s_getreg((3 << 11) | 20) & 0xFu; }
#define XB_SPIN(cond, bar) do { unsigned _sp = 0; while (cond) { __builtin_amdgcn_s_sleep(1); \
    if ((++_sp & 255u) == 0u) { if (xb_ld(&(bar)[XB_TMO])) break; if (_sp > XB_SPIN_CAP) { atomicAdd(&(bar)[XB_TMO], 1u); break; } } } } while (0)
__device__ __forceinline__ void xcd_barrier_complete(unsigned* bar, unsigned x, unsigned& nloc, unsigned& nx) {
  const unsigned G = GRID;
  unsigned sum, cnt, mine, sp = 0u;
  for (;;) {
    sum = 0u; cnt = 0u; mine = 0u;
#pragma unroll
    for (unsigned j = 0; j < 16; ++j) { const unsigned c = xb_ld(&bar[XB_XCNT(j)]); sum += c; cnt += (c > 0u) ? 1u : 0u; mine = (j == x) ? c : mine; }
    if (sum == G) break;
    __builtin_amdgcn_s_sleep(1);
    if ((++sp & 255u) == 0u) { if (xb_ld(&bar[XB_TMO])) break; if (sp > XB_SPIN_CAP) { atomicAdd(&bar[XB_TMO], 1u); break; } }
  }
  nloc = mine > 0u ? mine : 1u; nx = cnt > 0u ? cnt : 1u;
}
__device__ __forceinline__ void xcd_barrier(KP kp) {
  asm volatile("s_waitcnt vmcnt(0)" ::: "memory");
  __syncthreads();
  if (threadIdx.x == 0) {
    unsigned* bar = reinterpret_cast<unsigned*>(kp->ws + OFF_BAR);
    volatile unsigned* st = reinterpret_cast<volatile unsigned*>(smem_raw + XB_LDS_OFF);
    const unsigned x = xb_xcc_id();
    __builtin_amdgcn_s_waitcnt(0);
    unsigned nloc = st[0], nx = st[1];
    if (nloc == 0u) { xcd_barrier_complete(bar, x, nloc, nx); st[0] = nloc; st[1] = nx; }
    const unsigned old = xb_add(&bar[XB_XSUB(x)], 1u);
    const unsigned gen = old / nloc;
    if (old + 1u == (gen + 1u) * nloc) {
      __builtin_amdgcn_fence(__ATOMIC_RELEASE, "agent");
      asm volatile("s_waitcnt vmcnt(0)" ::: "memory");
      const unsigned og = xb_add(&bar[XB_TOP], 1u);
      const unsigned tg = og / nx;
      if (og + 1u == (tg + 1u) * nx) xb_add(&bar[XB_TOPGEN], 1u);
      else XB_SPIN(xb_ld(&bar[XB_TOPGEN]) == tg, bar);
      __builtin_amdgcn_fence(__ATOMIC_ACQUIRE, "agent");
      xb_add(&bar[XB_XGEN(x)], 1u);
      asm volatile("s_waitcnt vmcnt(0)" ::: "memory");
    } else {
      XB_SPIN(xb_ld(&bar[XB_XGEN(x)]) == gen, bar);
      __builtin_amdgcn_fence(__ATOMIC_ACQUIRE, "agent");
      asm volatile("s_waitcnt vmcnt(0)" ::: "memory");
    }
  }
  __syncthreads();
}

__device__ __forceinline__ unsigned cvt_pk_bf16(float lo, float hi) {
  unsigned r;
  asm volatile("v_cvt_pk_bf16_f32 %0, %1, %2" : "=v"(r) : "v"(lo), "v"(hi));
  return r;
}
__device__ __forceinline__ float bf_lo(unsigned u) { return __uint_as_float(u << 16); }
__device__ __forceinline__ float bf_hi(unsigned u) { return __uint_as_float(u & 0xffff0000u); }
__device__ __forceinline__ void unpack8(const uint4& r, float* f) {
  f[0] = bf_lo(r.x); f[1] = bf_hi(r.x); f[2] = bf_lo(r.y); f[3] = bf_hi(r.y);
  f[4] = bf_lo(r.z); f[5] = bf_hi(r.z); f[6] = bf_lo(r.w); f[7] = bf_hi(r.w);
}
__device__ __forceinline__ void load8(const bf16* p, float* f) {
  uint4 r = *reinterpret_cast<const uint4*>(p);
  unpack8(r, f);
}
__device__ __forceinline__ void store4bf(bf16* p, float a, float b, float c, float d) {
  uint2 o; o.x = cvt_pk_bf16(a, b); o.y = cvt_pk_bf16(c, d);
  *reinterpret_cast<uint2*>(p) = o;
}
__device__ __forceinline__ float sigmoidf_(float x) { return 1.f / (1.f + __expf(-x)); }
__device__ __forceinline__ float tanhf_(float x) { const float t = __expf(-2.f * fabsf(x)); return copysignf((1.f - t) / (1.f + t), x); }
__device__ __forceinline__ float softplusf_(float z) { return fmaxf(z, 0.f) + __logf(1.f + __expf(-fabsf(z))); }

constexpr int BM = 256, BK = 64, HALF = 128, NXCD = 8, WGM = 8, HT = HALF * BK;
#define shm ((bf16*)smem_raw)

__device__ __forceinline__ int lds_byte(int r, int c) {
  int st = (r >> 4) * 2 + (c >> 5), rr = r & 15, cc = c & 31, ob = rr * 64 + cc * 2;
  return st * 1024 + (ob ^ (((ob >> 9) & 1) << 5));
}
__device__ __forceinline__ void stage_rc(int b, int& R, int& C) {
  int st = b / 1024, sb = b % 1024, swz = sb ^ (((sb >> 9) & 1) << 5);
  R = (st >> 1) * 16 + swz / 64; C = (st & 1) * 32 + (swz % 64) / 2;
}

#define SA(b, h) (shm + ((b) * 2 + (h)) * HT)
#define SB(b, h) (shm + (4 + (b) * 2 + (h)) * HT)
#define STAGE(P, BASE, br, kt) do { long _g = (long)(br) * K + (long)(kt) * BK; \
    for (int _i = 0; _i < 2; ++_i) { int _b = tid * 16 + _i * 8192; int _r, _c; stage_rc(_b, _r, _c); \
      __builtin_amdgcn_global_load_lds((const unsigned*)(BASE + _g + (long)_r * K + _c), \
        (unsigned*)((char*)(P) + _b), 16, 0, 0); } } while (0)
#define LDA(dst, b, h) for (int m = 0; m < 4; ++m) for (int k = 0; k < 2; ++k) \
    dst[m][k] = *reinterpret_cast<const bf16x8*>((char*)SA(b, h) + lds_byte(wr * 64 + m * 16 + fr, k * 32 + fq * 8))
#define LDB(dst, b, h) for (int n = 0; n < 2; ++n) for (int k = 0; k < 2; ++k) \
    dst[n][k] = *reinterpret_cast<const bf16x8*>((char*)SB(b, h) + lds_byte(wc * 32 + n * 16 + fr, k * 32 + fq * 8))
#define MMA(ai, bj, At, Bt_) do { __builtin_amdgcn_s_setprio(1); \
    for (int m = 0; m < 4; ++m) for (int n = 0; n < 2; ++n) for (int k = 0; k < 2; ++k) \
      acc[ai][bj][m][n] = __builtin_amdgcn_mfma_f32_16x16x32_bf16(Bt_[n][k], At[m][k], acc[ai][bj][m][n], 0, 0, 0); \
    __builtin_amdgcn_s_setprio(0); } while (0)
#define WAIT_V(n) asm volatile("s_waitcnt vmcnt(" #n ")" ::: "memory")
#define WAIT_L(n) asm volatile("s_waitcnt lgkmcnt(" #n ")" ::: "memory")
#define BAR __builtin_amdgcn_s_barrier()
#define SCHED __builtin_amdgcn_sched_barrier(0)

typedef f32x4 AccT[2][2][4][2];

__device__ __forceinline__ void gemm_one(const int tid_in, const bf16* __restrict__ A, const bf16* __restrict__ Bt, const int K_in,
                                         const int brow, const int bcol, AccT& acc) {
  int tid = tid_in; asm volatile("" : "+v"(tid));
  const int K = K_in;
  const int wid = tid >> 6, lane = tid & 63, wr = wid >> 2, wc = wid & 3, fr = lane & 15, fq = lane >> 4;
#pragma unroll
  for (int a = 0; a < 2; ++a)
#pragma unroll
    for (int b = 0; b < 2; ++b)
#pragma unroll
      for (int m = 0; m < 4; ++m)
#pragma unroll
        for (int n = 0; n < 2; ++n) acc[a][b][m][n] = f32x4{0.f, 0.f, 0.f, 0.f};
  bf16x8 At[4][2], B0[2][2], B1[2][2];
  const int nt = K / BK;
  STAGE(SB(0, 0), Bt, bcol, 0); STAGE(SA(0, 0), A, brow, 0);
  STAGE(SB(0, 1), Bt, bcol + HALF, 0); STAGE(SA(0, 1), A, brow + HALF, 0);
  if (wr == 1) BAR;
  WAIT_V(4); BAR;
  STAGE(SB(1, 0), Bt, bcol, 1); STAGE(SA(1, 0), A, brow, 1); STAGE(SB(1, 1), Bt, bcol + HALF, 1);
  WAIT_V(6); BAR;
#pragma unroll 1
  for (int t = 0; t < nt - 2; t += 2) {
    LDB(B0, 0, 0); SCHED; LDA(At, 0, 0); STAGE(SA(1, 1), A, brow + HALF, t + 1);
    WAIT_L(8); BAR; WAIT_L(0); MMA(0, 0, At, B0); BAR; SCHED;
    LDB(B1, 0, 1); STAGE(SB(0, 0), Bt, bcol, t + 2);
    BAR; WAIT_L(0); MMA(0, 1, At, B1); BAR;
    LDA(At, 0, 1); STAGE(SA(0, 0), A, brow, t + 2);
    BAR; WAIT_L(0); MMA(1, 0, At, B0); BAR; SCHED;
    STAGE(SB(0, 1), Bt, bcol + HALF, t + 2);
    WAIT_V(6); BAR; MMA(1, 1, At, B1); BAR;
    LDB(B0, 1, 0); SCHED; LDA(At, 1, 0); STAGE(SA(0, 1), A, brow + HALF, t + 2);
    WAIT_L(8); BAR; WAIT_L(0); MMA(0, 0, At, B0); BAR; SCHED;
    LDB(B1, 1, 1); STAGE(SB(1, 0), Bt, bcol, t + 3);
    BAR; WAIT_L(0); MMA(0, 1, At, B1); BAR;
    LDA(At, 1, 1); STAGE(SA(1, 0), A, brow, t + 3);
    BAR; WAIT_L(0); MMA(1, 0, At, B0); BAR; SCHED;
    STAGE(SB(1, 1), Bt, bcol + HALF, t + 3);
    WAIT_V(6); BAR; MMA(1, 1, At, B1); BAR;
  }
  { LDB(B0, 0, 0); LDA(At, 0, 0); STAGE(SA(1, 1), A, brow + HALF, nt - 1);
    BAR; WAIT_L(0); MMA(0, 0, At, B0); BAR;
    LDB(B1, 0, 1); BAR; WAIT_L(0); MMA(0, 1, At, B1); BAR;
    LDA(At, 0, 1); WAIT_V(4); BAR; WAIT_L(0); MMA(1, 0, At, B0); MMA(1, 1, At, B1); BAR; }
  { LDB(B0, 1, 0); LDA(At, 1, 0); WAIT_V(2); BAR; WAIT_L(0); MMA(0, 0, At, B0); BAR;
    LDB(B1, 1, 1); WAIT_V(0); BAR; WAIT_L(0); MMA(0, 1, At, B1); BAR;
    LDA(At, 1, 1); BAR; WAIT_L(0); MMA(1, 0, At, B0); MMA(1, 1, At, B1); BAR; }
  if (wr == 0) BAR;
}

__device__ __forceinline__ void tile_rc(int L, int nM, int nN, int& brow, int& bcol) {
  const int nwg = nM * nN;
  int wgid = L;
  { const int q = nwg / NXCD, r = nwg % NXCD, xcd = wgid % NXCD, off = wgid / NXCD;
    wgid = (xcd < r ? xcd * (q + 1) : r * (q + 1) + (xcd - r) * q) + off; }
  const int nig = WGM * nN, gid = wgid / nig, fm = gid * WGM, gsz = (nM - fm) < WGM ? (nM - fm) : WGM;
  const int pm = fm + ((wgid % nig) % gsz), pn = (wgid % nig) / gsz;
  brow = pm * BM; bcol = pn * BM;
}

#define EPI_VARS int tide_ = tid; asm volatile("" : "+v"(tide_)); const int wid_ = tide_ >> 6, lane_ = tide_ & 63, wr_ = wid_ >> 2, wc_ = wid_ & 3, fr_ = lane_ & 15, fq_ = lane_ >> 4;
#define EPI_LOOP _Pragma("unroll") for (int ai = 0; ai < 2; ++ai) _Pragma("unroll") for (int bj = 0; bj < 2; ++bj) \
    _Pragma("unroll") for (int m = 0; m < 4; ++m) _Pragma("unroll") for (int n = 0; n < 2; ++n)
#define EPI_ROW (brow + ai * 128 + wr_ * 64 + m * 16 + fr_)
#define EPI_COL (bcol + bj * 128 + wc_ * 32 + n * 16 + fq_ * 4)

__device__ __forceinline__ void ph_ffn_a(const bf16* H16, const bf16* Wgu, bf16* ACT) {
  PHASE_TID
  const int nM = MTOK / 256, nN = 5632 / 256;
  for (int L = bid; L < nM * nN; L += GRID) {
    int brow, bcol; tile_rc(L, nM, nN, brow, bcol);
    AccT acc; gemm_one(tid, H16, Wgu, DM, brow, bcol, acc);
    EPI_VARS
    const int u0 = (bcol >> 1);
#pragma unroll
    for (int ai = 0; ai < 2; ++ai)
#pragma unroll
      for (int m = 0; m < 4; ++m)
#pragma unroll
        for (int n = 0; n < 2; ++n) {
          const int row = brow + ai * 128 + wr_ * 64 + m * 16 + fr_;
          const int unit = u0 + wc_ * 32 + n * 16 + fq_ * 4;
          f32x4 g = acc[ai][0][m][n], u = acc[ai][1][m][n];
          float o[4];
#pragma unroll
          for (int j = 0; j < 4; ++j) o[j] = g[j] * sigmoidf_(g[j]) * u[j];
          store4bf(ACT + (size_t)row * DFF + unit, o[0], o[1], o[2], o[3]);
        }
  }
}
template <bool NORM>
__device__ __forceinline__ void ph_res(const bf16* A, const bf16* Bt, int K, float* H32, float scale, const float2* stats, const float* lg, const float* lb, const float* src = nullptr) {
  PHASE_TID
  const int nM = MTOK / 256, nN = DM / 256;
  for (int L = bid; L < nM * nN; L += GRID) {
    int brow, bcol; tile_rc(L, nM, nN, brow, bcol);
    AccT acc; gemm_one(tid, A, Bt, K, brow, bcol, acc);
    EPI_VARS
#pragma unroll
    for (int ai = 0; ai < 2; ++ai)
#pragma unroll
      for (int m = 0; m < 4; ++m) {
        const int row = brow + ai * 128 + wr_ * 64 + m * 16 + fr_;
        float2 st = make_float2(0.f, 1.f);
        if (NORM) st = stats[row];
#pragma unroll
        for (int bj = 0; bj < 2; ++bj)
#pragma unroll
          for (int n = 0; n < 2; ++n) {
            const int col = EPI_COL;
            float4* p = reinterpret_cast<float4*>(H32 + (size_t)row * DM + col);
            float4 v = NORM ? *p : *reinterpret_cast<const float4*>(src + (size_t)row * DM + col);
            f32x4 a = acc[ai][bj][m][n];
            if (NORM) {
              const float4 g4 = *reinterpret_cast<const float4*>(lg + col), b4 = *reinterpret_cast<const float4*>(lb + col);
              v.x = (v.x - st.x) * st.y * g4.x + b4.x; v.y = (v.y - st.x) * st.y * g4.y + b4.y;
              v.z = (v.z - st.x) * st.y * g4.z + b4.z; v.w = (v.w - st.x) * st.y * g4.w + b4.w;
            }
            v.x = ALPHA_F * v.x + scale * a[0]; v.y = ALPHA_F * v.y + scale * a[1];
            v.z = ALPHA_F * v.z + scale * a[2]; v.w = ALPHA_F * v.w + scale * a[3];
            *p = v;
            __builtin_amdgcn_sched_barrier(0);
          }
      }
  }
}
template <bool SIG>
__device__ __forceinline__ void ph_proj(const bf16* A, const bf16* Bt, int N, int K, bf16* C, int ldc) {
  PHASE_TID
  const int nM = MTOK / 256, nN = N / 256;
  for (int L = bid; L < nM * nN; L += GRID) {
    int brow, bcol; tile_rc(L, nM, nN, brow, bcol);
    AccT acc; gemm_one(tid, A, Bt, K, brow, bcol, acc);
    EPI_VARS
    EPI_LOOP {
      f32x4 a = acc[ai][bj][m][n];
      if (SIG) { a[0] = sigmoidf_(a[0]); a[1] = sigmoidf_(a[1]); a[2] = sigmoidf_(a[2]); a[3] = sigmoidf_(a[3]); }
      store4bf(C + (size_t)EPI_ROW * ldc + EPI_COL, a[0], a[1], a[2], a[3]);
    }
  }
}
__device__ __forceinline__ void ph_merge(const bf16* Y0, const bf16* Y1, const bf16* Y2, const bf16* Wbr, const bf16* GATE, float* M32, bf16* OUT16) {
  PHASE_TID
  const int nM = MTOK / 256, nN = DM / 256;
  for (int L = bid; L < nM * nN; L += GRID) {
    int brow, bcol; tile_rc(L, nM, nN, brow, bcol);
#pragma unroll 1
    for (int br = 0; br < 3; ++br) {
      const bf16* Y = br == 0 ? Y0 : (br == 1 ? Y1 : Y2);
      AccT acc; gemm_one(tid, Y, Wbr + (size_t)br * 1024 * 512, 512, brow, bcol, acc);
      EPI_VARS
      EPI_LOOP {
        const size_t row = EPI_ROW; const int col = EPI_COL;
        uint2 gr = *reinterpret_cast<const uint2*>(GATE + row * 3072 + br * 1024 + col);
        f32x4 a = acc[ai][bj][m][n];
        float z0 = bf_lo(gr.x) * a[0], z1 = bf_hi(gr.x) * a[1], z2 = bf_lo(gr.y) * a[2], z3 = bf_hi(gr.y) * a[3];
        bf16* p = reinterpret_cast<bf16*>(M32) + row * DM + col;
        if (br == 0) { store4bf(p, z0, z1, z2, z3); }
        else {
          const uint2 pr = *reinterpret_cast<const uint2*>(p);
          const float v0 = bf_lo(pr.x) + z0, v1 = bf_hi(pr.x) + z1, v2 = bf_lo(pr.y) + z2, v3 = bf_hi(pr.y) + z3;
          if (br == 1) store4bf(p, v0, v1, v2, v3); else store4bf(OUT16 + row * DM + col, v0, v1, v2, v3);
        }
        __builtin_amdgcn_sched_barrier(0);
      }
    }
  }
}
__device__ __forceinline__ void ph_ple(const bf16* H16, const bf16* P16, const bf16* Wpg, const bf16* Wpp, float* T32, float* H32, const float2* stats, const float* lg, const float* lb) {
  PHASE_TID
  const int nM = MTOK / 256, nN = DM / 256;
  for (int L = bid; L < nM * nN; L += GRID) {
    int brow, bcol; tile_rc(L, nM, nN, brow, bcol);
    {
      AccT acc; gemm_one(tid, P16, Wpp, 256, brow, bcol, acc);
      EPI_VARS
      EPI_LOOP {
        f32x4 a = acc[ai][bj][m][n];
        store4bf(reinterpret_cast<bf16*>(T32) + (size_t)EPI_ROW * DM + EPI_COL, a[0], a[1], a[2], a[3]);
        __builtin_amdgcn_sched_barrier(0);
      }
    }
    {
      AccT acc; gemm_one(tid, H16, Wpg, DM, brow, bcol, acc);
      EPI_VARS
      EPI_LOOP {
        const int row_ = EPI_ROW, col_ = EPI_COL;
        const size_t o = (size_t)row_ * DM + col_;
        const uint2 tr_ = *reinterpret_cast<const uint2*>(reinterpret_cast<const bf16*>(T32) + o);
        const float4 t = make_float4(bf_lo(tr_.x), bf_hi(tr_.x), bf_lo(tr_.y), bf_hi(tr_.y));
        float4* p = reinterpret_cast<float4*>(H32 + o);
        float4 v = *p; f32x4 a = acc[ai][bj][m][n];
        {
          const float2 st = stats[row_];
          const float4 g4 = *reinterpret_cast<const float4*>(lg + col_), b4 = *reinterpret_cast<const float4*>(lb + col_);
          v.x = (v.x - st.x) * st.y * g4.x + b4.x; v.y = (v.y - st.x) * st.y * g4.y + b4.y;
          v.z = (v.z - st.x) * st.y * g4.z + b4.z; v.w = (v.w - st.x) * st.y * g4.w + b4.w;
        }
        v.x = ALPHA_F * v.x + sigmoidf_(a[0]) * t.x; v.y = ALPHA_F * v.y + sigmoidf_(a[1]) * t.y;
        v.z = ALPHA_F * v.z + sigmoidf_(a[2]) * t.z; v.w = ALPHA_F * v.w + sigmoidf_(a[3]) * t.w;
        *p = v;
        __builtin_amdgcn_sched_barrier(0);
      }
    }
  }
}

__device__ __forceinline__ float wave_sum(float v) {
#pragma unroll
  for (int o = 1; o < 64; o <<= 1) v += __shfl_xor(v, o);
  return v;
}
__device__ __forceinline__ void ph_ln(float* H32, bf16* H16, const float* g, const float* b, float* outp, float2* stats) {
  PHASE_TID
  const int lane = tid & 63, wave = tid >> 6;
  float4 gg[4], bb[4];
#pragma unroll
  for (int j = 0; j < 4; ++j) { gg[j] = reinterpret_cast<const float4*>(g)[lane + 64 * j]; bb[j] = reinterpret_cast<const float4*>(b)[lane + 64 * j]; }
  for (int row = bid * 8 + wave; row < MTOK; row += GRID * 8) {
    float4* xr = reinterpret_cast<float4*>(H32 + (size_t)row * DM);
    float4 v[4]; float s = 0.f;
#pragma unroll
    for (int j = 0; j < 4; ++j) { v[j] = xr[lane + 64 * j]; s += (v[j].x + v[j].y) + (v[j].z + v[j].w); }
    const float mean = wave_sum(s) * (1.f / DM);
    float s2 = 0.f;
#pragma unroll
    for (int j = 0; j < 4; ++j) {
      v[j].x -= mean; v[j].y -= mean; v[j].z -= mean; v[j].w -= mean;
      s2 += (v[j].x * v[j].x + v[j].y * v[j].y) + (v[j].z * v[j].z + v[j].w * v[j].w);
    }
    const float rstd = rsqrtf(wave_sum(s2) * (1.f / DM) + 1e-5f);
#pragma unroll
    for (int j = 0; j < 4; ++j) {
      float4 y;
      y.x = v[j].x * rstd * gg[j].x + bb[j].x; y.y = v[j].y * rstd * gg[j].y + bb[j].y;
      y.z = v[j].z * rstd * gg[j].z + bb[j].z; y.w = v[j].w * rstd * gg[j].w + bb[j].w;
      if (outp) { reinterpret_cast<float4*>(outp + (size_t)row * DM)[lane + 64 * j] = y; }
      else {
        store4bf(H16 + (size_t)row * DM + (lane + 64 * j) * 4, y.x, y.y, y.z, y.w);
      }
    }
    if (!outp && lane == 0) stats[row] = make_float2(mean, rstd);
  }
}

__device__ __forceinline__ void ph_pconv(KP P, int layer) {
  PHASE_TID
  const size_t gt = (size_t)bid * 512 + tid, gn = (size_t)GRID * 512;
  const float4* src = reinterpret_cast<const float4*>(P->in[1] + (size_t)layer * MTOK * 256);
  bf16* dst = reinterpret_cast<bf16*>(P->ws + OFF_P16);
  for (size_t i = gt; i < (size_t)MTOK * 256 / 4; i += gn) { float4 v = src[i]; store4bf(dst + i * 4, v.x, v.y, v.z, v.w); }
}
__device__ __forceinline__ void conv_mat(const int tid, const int bid, const float* W, int ldw, int col0, int ncols, int K, bf16* WT, int mode, const int nblocks = GRID) {
  const int lane = tid & 63, wave = tid >> 6;
  float* scr = reinterpret_cast<float*>(smem_raw) + wave * (64 * 33);
  const int nblk = ncols / 32, nitems = (K / 64) * nblk;
  for (int item = bid * 8 + wave; item < nitems; item += nblocks * 8) {
    const int kb = item / nblk, nb = item % nblk, k0 = 64 * kb, n0 = 32 * nb;
    {
      float v[32];
      const float* src = W + (size_t)(k0 + (lane >> 5)) * ldw + col0 + n0 + (lane & 31);
#pragma unroll
      for (int i = 0; i < 32; ++i) v[i] = src[(size_t)(2 * i) * ldw];
#pragma unroll
      for (int i = 0; i < 32; ++i) scr[(2 * i + (lane >> 5)) * 33 + (lane & 31)] = v[i];
    }
    __builtin_amdgcn_wave_barrier(); asm volatile("s_waitcnt lgkmcnt(0)" ::: "memory");
    const int c = lane & 7;
#pragma unroll
    for (int j = 0; j < 4; ++j) {
      const int n = (lane >> 3) + 8 * j; const float* s = scr + (8 * c) * 33 + n;
      uint4 o; o.x = cvt_pk_bf16(s[0 * 33], s[1 * 33]); o.y = cvt_pk_bf16(s[2 * 33], s[3 * 33]);
      o.z = cvt_pk_bf16(s[4 * 33], s[5 * 33]); o.w = cvt_pk_bf16(s[6 * 33], s[7 * 33]);
      const int nn = n0 + n;
      const int drow = mode == 0 ? nn : ((nn >> 7) * 256 + (nn & 127) + (mode == 2 ? 128 : 0));
      *reinterpret_cast<uint4*>(WT + (size_t)drow * K + k0 + 8 * c) = o;
    }
    __builtin_amdgcn_wave_barrier(); asm volatile("s_waitcnt lgkmcnt(0)" ::: "memory");
  }
}
__device__ __forceinline__ void ph_convert(KP P, int layer, bool first) {
  PHASE_TID
  bf16* W = reinterpret_cast<bf16*>(P->ws + OFF_W);
  const size_t l = layer;
  if (first) {
    conv_mat(tid, bid, P->in[4] + l * DM * DFF, DFF, 0, DFF, DM, W + W_F1GU, 1);
    conv_mat(tid, bid, P->in[5] + l * DM * DFF, DFF, 0, DFF, DM, W + W_F1GU, 2);
    conv_mat(tid, bid, P->in[6] + l * DFF * DM, DM, 0, DM, DFF, W + W_F1D, 0);
  }
  const float* win = P->in[7] + l * DM * 8480;
  conv_mat(tid, bid, win, 8480, 0, 1824, DM, W + W_RW, 0);
  conv_mat(tid, bid, win, 8480, 1824, 1536, DM, W + W_SB, 0);
  conv_mat(tid, bid, win, 8480, 3360, 2048, DM, W + W_HG, 0);
  conv_mat(tid, bid, win, 8480, 5408, 3072, DM, W + W_GATE, 0);
  conv_mat(tid, bid, P->in[21] + l * 512 * DM, DM, 0, DM, 512, W + W_BR, 0);
  conv_mat(tid, bid, P->in[22] + l * 512 * DM, DM, 0, DM, 512, W + W_BR + 1024 * 512, 0);
  conv_mat(tid, bid, P->in[23] + l * 512 * DM, DM, 0, DM, 512, W + W_BR + 2 * 1024 * 512, 0);
  conv_mat(tid, bid, P->in[24] + l * DM * DM, DM, 0, DM, DM, W + W_OUT, 0);
  conv_mat(tid, bid, P->in[28] + l * DM * DM, DM, 0, DM, DM, W + W_PG, 0);
  conv_mat(tid, bid, P->in[29] + l * 256 * DM, DM, 0, DM, 256, W + W_PP, 0);
  const size_t gt = (size_t)bid * 512 + tid, gn = (size_t)GRID * 512;
  { uint4 z = make_uint4(0, 0, 0, 0); uint4* d = reinterpret_cast<uint4*>(W + W_RW + (size_t)1824 * DM);
    for (size_t i = gt; i < (size_t)224 * DM / 8; i += gn) d[i] = z; }
  if (first) {
    const float4* src = reinterpret_cast<const float4*>(P->in[0]);
    bf16* h16 = reinterpret_cast<bf16*>(P->ws + OFF_H16);
    for (size_t i = gt; i < (size_t)MTOK * DM / 4; i += gn) { float4 v = src[i]; store4bf(h16 + i * 4, v.x, v.y, v.z, v.w); }
  }
}

#define MMK(KK, AEXPR, BEXPR) _Pragma("unroll 2") for (int k0_ = 0; k0_ < (KK); k0_ += 16) { _Pragma("unroll") for (int st_ = 0; st_ < 4; ++st_) { const int k = k0_ + 4 * kq + st_; \
    _Pragma("unroll") for (int u_ = 0; u_ < 2; ++u_) { const int i = ii[u_], j = jj[u_]; \
      acc[u_] = __builtin_amdgcn_mfma_f32_16x16x4f32((AEXPR), (BEXPR), acc[u_], 0, 0, 0); } } }
#define MMKG(KK, AEXPR, BEXPR) _Pragma("unroll 2") for (int k0_ = 0; k0_ < (KK); k0_ += 16) { _Pragma("unroll") for (int st_ = 0; st_ < 4; ++st_) { const int k = k0_ + 4 * kq + st_; \
    _Pragma("unroll") for (int u_ = 0; u_ < 2; ++u_) { const int i = ii[u_], j = jj[u_]; \
      acc[u_] = __builtin_amdgcn_mfma_f32_16x16x4f32((AEXPR), (BEXPR), acc[u_], 0, 0, 0); } } }
template <int TM, int TN, class FK, class FC>
__device__ __forceinline__ void mm16(const int tid, FK fk, FC fc) {
  const int wave = tid >> 6, lane = tid & 63, li = lane & 15, kq = lane >> 4;
#pragma unroll 1
  for (int t = wave; t < TM * TN; t += 16) {
    const int t1 = t + 8;
    const int ti0 = t / TN, tj0 = t % TN, ti1 = t1 / TN, tj1 = t1 % TN;
    f32x4 acc[2] = {f32x4{0.f, 0.f, 0.f, 0.f}, f32x4{0.f, 0.f, 0.f, 0.f}};
    const int ii[2] = {ti0 * 16 + li, ti1 * 16 + li}, jj[2] = {tj0 * 16 + li, tj1 * 16 + li};
    fk(acc, ii, jj, kq);
#pragma unroll
    for (int r = 0; r < 4; ++r) fc(ti0 * 16 + kq * 4 + r, tj0 * 16 + li, acc[0][r]);
#pragma unroll
    for (int r = 0; r < 4; ++r) fc(ti1 * 16 + kq * 4 + r, tj1 * 16 + li, acc[1][r]);
  }
}

template <int TM, int TN, int K, class FC>
__device__ __forceinline__ void mmb(const int tid, const bf16* A, const int lda, const bf16* B, const int ldb, FC fc) {
  const int wave = tid >> 6, lane = tid & 63, li = lane & 15, kq = lane >> 4;
#pragma unroll 1
  for (int t = wave; t < TM * TN; t += 16) {
    const int t1 = t + 8;
    const int ti0 = t / TN, tj0 = t % TN, ti1 = t1 / TN, tj1 = t1 % TN;
    f32x4 acc0 = {0.f, 0.f, 0.f, 0.f}, acc1 = {0.f, 0.f, 0.f, 0.f};
    const bf16* a0 = A + (ti0 * 16 + li) * lda + kq * 8;
    const bf16* a1 = A + (ti1 * 16 + li) * lda + kq * 8;
    const bf16* b0 = B + (tj0 * 16 + li) * ldb + kq * 8;
    const bf16* b1 = B + (tj1 * 16 + li) * ldb + kq * 8;
#pragma unroll
    for (int kk = 0; kk < K; kk += 32) {
      acc0 = __builtin_amdgcn_mfma_f32_16x16x32_bf16(*reinterpret_cast<const bf16x8*>(a0 + kk), *reinterpret_cast<const bf16x8*>(b0 + kk), acc0, 0, 0, 0);
      acc1 = __builtin_amdgcn_mfma_f32_16x16x32_bf16(*reinterpret_cast<const bf16x8*>(a1 + kk), *reinterpret_cast<const bf16x8*>(b1 + kk), acc1, 0, 0, 0);
    }
#pragma unroll
    for (int r = 0; r < 4; ++r) fc(ti0 * 16 + kq * 4 + r, tj0 * 16 + li, acc0[r]);
#pragma unroll
    for (int r = 0; r < 4; ++r) fc(ti1 * 16 + kq * 4 + r, tj1 * 16 + li, acc1[r]);
  }
}
__device__ __forceinline__ void scatter8(const uint4 r, unsigned short* dst, int ld) {
  dst[0 * ld] = (unsigned short)(r.x & 0xffff); dst[1 * ld] = (unsigned short)(r.x >> 16);
  dst[2 * ld] = (unsigned short)(r.y & 0xffff); dst[3 * ld] = (unsigned short)(r.y >> 16);
  dst[4 * ld] = (unsigned short)(r.z & 0xffff); dst[5 * ld] = (unsigned short)(r.z >> 16);
  dst[6 * ld] = (unsigned short)(r.w & 0xffff); dst[7 * ld] = (unsigned short)(r.w >> 16);
}

__device__ __forceinline__ void ph_sb(const bf16* U, bf16* YSB) {
  bf16* Qb = reinterpret_cast<bf16*>(smem_raw);
  bf16* Kb = Qb + 64 * 136;
  bf16* Vt = Kb + 64 * 136;
  bf16* Ab = Vt + 128 * 72;
  float* Zs = reinterpret_cast<float*>(Ab + 64 * 72);
  PHASE_TID
  const int wave = tid >> 6, lane = tid & 63, li = lane & 15, kq = lane >> 4;
  for (int task = bid; task < 2048; task += GRID) {
    const int qt = task & 127, h = (task >> 7) & 3, b = task >> 9;
    const size_t tok0 = (size_t)b * SEQ + qt * 64;
    const int e0 = tid, e1 = tid + 512;
    const bf16* kbase = U + (size_t)b * SEQ * LDU + 512 + h * 128;
    const bf16* vbase = U + (size_t)b * SEQ * LDU + 1024 + h * 128;
    const size_t ko0 = (size_t)(e0 >> 4) * LDU + (e0 & 15) * 8, ko1 = (size_t)(e1 >> 4) * LDU + (e1 & 15) * 8;
    const size_t vo0 = (size_t)(e0 & 63) * LDU + (e0 >> 6) * 8, vo1 = (size_t)(e1 & 63) * LDU + (e1 >> 6) * 8;
    uint4 kr0, kr1, vr0, vr1;
    {
      const size_t kt0 = (size_t)qt * 64 * LDU;
      kr0 = *reinterpret_cast<const uint4*>(kbase + kt0 + ko0); kr1 = *reinterpret_cast<const uint4*>(kbase + kt0 + ko1);
      vr0 = *reinterpret_cast<const uint4*>(vbase + kt0 + vo0); vr1 = *reinterpret_cast<const uint4*>(vbase + kt0 + vo1);
    }
    __syncthreads();
#pragma unroll
    for (int i = 0; i < 2; ++i) {
      const int e = tid + 512 * i, r = e >> 4, c8 = (e & 15) * 8;
      *reinterpret_cast<uint4*>(Qb + r * 136 + c8) = *reinterpret_cast<const uint4*>(U + (tok0 + r) * LDU + h * 128 + c8);
    }
    f32x4 o[4];
#pragma unroll
    for (int c = 0; c < 4; ++c) o[c] = f32x4{0.f, 0.f, 0.f, 0.f};
    float carry = 0.f;
    const int row = tid >> 3, part = tid & 7;
    const int rt = wave & 3, cb = (wave >> 2) * 64;
    for (int kt = qt; kt >= 0; --kt) {
      __syncthreads();
      *reinterpret_cast<uint4*>(Kb + (e0 >> 4) * 136 + (e0 & 15) * 8) = kr0;
      *reinterpret_cast<uint4*>(Kb + (e1 >> 4) * 136 + (e1 & 15) * 8) = kr1;
      scatter8(vr0, reinterpret_cast<unsigned short*>(Vt) + ((e0 >> 6) * 8) * 72 + (e0 & 63), 72);
      scatter8(vr1, reinterpret_cast<unsigned short*>(Vt) + ((e1 >> 6) * 8) * 72 + (e1 & 63), 72);
      if (kt > 0) {
        const size_t kt0 = (size_t)(kt - 1) * 64 * LDU;
        kr0 = *reinterpret_cast<const uint4*>(kbase + kt0 + ko0); kr1 = *reinterpret_cast<const uint4*>(kbase + kt0 + ko1);
        vr0 = *reinterpret_cast<const uint4*>(vbase + kt0 + vo0); vr1 = *reinterpret_cast<const uint4*>(vbase + kt0 + vo1);
      }
      __syncthreads();
      mmb<4, 4, 128>(tid, Qb, 136, Kb, 136, [&](int r, int c, float v) { Zs[r * 68 + c] = v * 0.08838834764831845f; });
      __syncthreads();
      {
        const float* zp = Zs + row * 68 + part * 8;
        const int qg = qt * 64 + row, kg0 = kt * 64 + part * 8;
        float z[8], w[8];
#pragma unroll
        for (int j = 0; j < 8; ++j) z[j] = zp[j];
        float run = 0.f;
#pragma unroll
        for (int j = 7; j >= 0; --j) { const bool valid = (kg0 + j) < qg; run += valid ? -softplusf_(z[j]) : 0.f; w[j] = run; }
        const float tot = run;
        float incl = tot;
#pragma unroll
        for (int d = 1; d < 8; d <<= 1) { const float o_ = __shfl_down(incl, d, 8); if (part + d < 8) incl += o_; }
        const float excl = incl - tot;
        float a[8];
#pragma unroll
        for (int j = 0; j < 8; ++j) { const bool valid = (kg0 + j) < qg; a[j] = valid ? __expf(z[j] + w[j] + excl + carry) : 0.f; }
        uint4 pk; pk.x = cvt_pk_bf16(a[0], a[1]); pk.y = cvt_pk_bf16(a[2], a[3]); pk.z = cvt_pk_bf16(a[4], a[5]); pk.w = cvt_pk_bf16(a[6], a[7]);
        *reinterpret_cast<uint4*>(Ab + row * 72 + part * 8) = pk;
        carry += __shfl(incl, 0, 8);
      }
      __syncthreads();
      {
        const bf16* ap = Ab + (rt * 16 + li) * 72 + kq * 8;
#pragma unroll
        for (int kk = 0; kk < 64; kk += 32) {
          const bf16x8 a = *reinterpret_cast<const bf16x8*>(ap + kk);
#pragma unroll
          for (int c = 0; c < 4; ++c)
            o[c] = __builtin_amdgcn_mfma_f32_16x16x32_bf16(a, *reinterpret_cast<const bf16x8*>(Vt + (cb + c * 16 + li) * 72 + kq * 8 + kk), o[c], 0, 0, 0);
        }
      }
      if (__syncthreads_and(carry < -90.f)) break;
    }
#pragma unroll
    for (int c = 0; c < 4; ++c)
#pragma unroll
      for (int r = 0; r < 4; ++r) {
        const int ri = rt * 16 + kq * 4 + r, col = cb + c * 16 + li;
        YSB[(tok0 + ri) * 512 + h * 128 + col] = __float2bfloat16(o[c][r]);
      }
  }
}

#define RB(i) (sm + (i) * 4352)
__device__ __forceinline__ void lerp8(const bf16* U, size_t tok, bool hasprev, int col, const float* mu, float* out) {
  float c[8], p[8];
  load8(U + tok * LDU + col, c);
  if (hasprev) load8(U + (tok - 1) * LDU + col, p);
  else {
#pragma unroll
    for (int j = 0; j < 8; ++j) p[j] = 0.f;
  }
  const float4 m0 = *reinterpret_cast<const float4*>(mu + col), m1 = *reinterpret_cast<const float4*>(mu + col + 4);
  const float mm[8] = {m0.x, m0.y, m0.z, m0.w, m1.x, m1.y, m1.z, m1.w};
#pragma unroll
  for (int j = 0; j < 8; ++j) out[j] = c[j] + (p[j] - c[j]) * mm[j];
}
__device__ __forceinline__ void store_bf16_at(bf16* p, float v) { *p = __float2bfloat16(v); }

__device__ __forceinline__ void ph_rwkv_a(KP P, int layer) {
  float* sm = reinterpret_cast<float*>(smem_raw);
  float* GL = sm + 8 * 4352;
  const bf16* U = reinterpret_cast<const bf16*>(P->ws + OFF_U);
  float* Pg = reinterpret_cast<float*>(P->ws + OFF_RP);
  float* Dg = reinterpret_cast<float*>(P->ws + OFF_RD);
  bf16* YIg = reinterpret_cast<bf16*>(P->ws + OFF_RYI);
  bf16* QEg = reinterpret_cast<bf16*>(P->ws + OFF_RQE);
  bf16* GTg = reinterpret_cast<bf16*>(P->ws + OFF_RGT);
  float* BCg = reinterpret_cast<float*>(P->ws + OFF_RBC);
  const float* mu = P->in[8] + (size_t)layer * 1824;
  const float* w0 = P->in[9] + (size_t)layer * 512;
  const float* wup = P->in[10] + (size_t)layer * 64 * 512;
  const float* a0 = P->in[11] + (size_t)layer * 512;
  const float* aup = P->in[12] + (size_t)layer * 64 * 512;
  const float* gup = P->in[13] + (size_t)layer * 160 * 512;
  const float* k_k = P->in[14] + (size_t)layer * 512;
  const float* k_a = P->in[15] + (size_t)layer * 512;
  const float* r_k = P->in[16] + (size_t)layer * 512;
  PHASE_TID
  const int et = tid >> 3, en = (tid & 7) * 8;
  for (int task = bid; task < 4096; task += GRID) {
    const int c = task & 127, h = (task >> 7) & 7, b = task >> 10;
    const size_t tok0 = (size_t)b * SEQ + c * 64;
    const size_t tok = tok0 + et;
    const bool hasprev = (c * 64 + et) > 0;
    const int hc = h * 64;
    float r[8], k[8], v[8], xw[8], xa[8];
    lerp8(U, tok, hasprev, 1536 + en, mu, xw);
    lerp8(U, tok, hasprev, 1600 + en, mu, xa);
    lerp8(U, tok, hasprev, hc + en, mu, r);
    lerp8(U, tok, hasprev, 512 + hc + en, mu, k);
    lerp8(U, tok, hasprev, 1024 + hc + en, mu, v);
    const int wk0 = tid >> 4, wc4 = (tid & 15) * 4;
    const float4 wu0 = *reinterpret_cast<const float4*>(wup + (size_t)wk0 * 512 + hc + wc4);
    const float4 wu1 = *reinterpret_cast<const float4*>(wup + (size_t)(wk0 + 32) * 512 + hc + wc4);
    const float4 au0 = *reinterpret_cast<const float4*>(aup + (size_t)wk0 * 512 + hc + wc4);
    const float4 au1 = *reinterpret_cast<const float4*>(aup + (size_t)(wk0 + 32) * 512 + hc + wc4);
    __syncthreads();
    bf16* XWb = reinterpret_cast<bf16*>(RB(0)); bf16* XAb = reinterpret_cast<bf16*>(RB(1));
    bf16* WUt = reinterpret_cast<bf16*>(RB(4)); bf16* AUt = reinterpret_cast<bf16*>(RB(5));
    {
      uint4 pw, pa;
      pw.x = cvt_pk_bf16(tanhf_(xw[0]), tanhf_(xw[1])); pw.y = cvt_pk_bf16(tanhf_(xw[2]), tanhf_(xw[3]));
      pw.z = cvt_pk_bf16(tanhf_(xw[4]), tanhf_(xw[5])); pw.w = cvt_pk_bf16(tanhf_(xw[6]), tanhf_(xw[7]));
      pa.x = cvt_pk_bf16(xa[0], xa[1]); pa.y = cvt_pk_bf16(xa[2], xa[3]); pa.z = cvt_pk_bf16(xa[4], xa[5]); pa.w = cvt_pk_bf16(xa[6], xa[7]);
      *reinterpret_cast<uint4*>(XWb + et * 72 + en) = pw;
      *reinterpret_cast<uint4*>(XAb + et * 72 + en) = pa;
#define T4(DST, LD, V, OFF) do { (DST)[0 * (LD) + (OFF)] = __float2bfloat16((V).x); (DST)[1 * (LD) + (OFF)] = __float2bfloat16((V).y); \
    (DST)[2 * (LD) + (OFF)] = __float2bfloat16((V).z); (DST)[3 * (LD) + (OFF)] = __float2bfloat16((V).w); } while (0)
      T4(WUt + wc4 * 72 + wk0, 72, wu0, 0); T4(WUt + wc4 * 72 + wk0, 72, wu1, 32);
      T4(AUt + wc4 * 72 + wk0, 72, au0, 0); T4(AUt + wc4 * 72 + wk0, 72, au1, 32);
    }
    __syncthreads();
    mmb<4, 4, 64>(tid, XWb, 72, WUt, 72,
                  [&](int rr, int cc, float val) { const float wp = w0[hc + cc] + val; RB(2)[rr * 68 + cc] = -__expf(-softplusf_(-wp) - 0.5f); });
    mmb<4, 4, 64>(tid, XAb, 72, AUt, 72,
                  [&](int rr, int cc, float val) { RB(3)[rr * 68 + cc] = sigmoidf_(a0[hc + cc] + val); });
    __syncthreads();
    mm16<4, 4>(tid, [&](f32x4* acc, const int* ii, const int* jj, int kq) { MMK(64, (k <= i ? 1.f : 0.f), RB(2)[k * 68 + j]) },
               [&](int rr, int cc, float val) { RB(0)[rr * 68 + cc] = val; if (rr == 63) GL[cc] = __expf(val); });
    __syncthreads();
    {
      float kk[8], ss = 0.f;
#pragma unroll
      for (int j = 0; j < 8; ++j) { kk[j] = k[j] * k_k[hc + en + j]; ss += kk[j] * kk[j]; }
      ss += __shfl_xor(ss, 1); ss += __shfl_xor(ss, 2); ss += __shfl_xor(ss, 4);
      const float inv = 1.f / fmaxf(sqrtf(ss), 1e-12f);
      float bc = 0.f;
#pragma unroll
      for (int j = 0; j < 8; ++j) {
        const int n = en + j, o = et * 68 + n;
        const float as = RB(3)[o], lw = RB(2)[o], g = RB(0)[o];
        const float kkn = kk[j] * inv;
        const float kp = k[j] * (1.f + (as - 1.f) * k_a[hc + n]);
        const float einv = __expf(-g);
        RB(4)[o] = -kkn * __expf(g - lw);
        RB(5)[o] = r[j] * __expf(g);
        RB(6)[o] = kkn * as * einv;
        RB(7)[o] = kp * einv;
        RB(1)[o] = v[j];
        bc += r[j] * kp * r_k[hc + n];
      }
      bc += __shfl_xor(bc, 1); bc += __shfl_xor(bc, 2); bc += __shfl_xor(bc, 4);
      if ((tid & 7) == 0) BCg[(size_t)task * 64 + et] = bc;
    }
    __syncthreads();
    mm16<4, 4>(tid, [&](f32x4* acc, const int* ii, const int* jj, int kq) { MMK(64, RB(4)[i * 68 + k], RB(6)[j * 68 + k]) },
               [&](int rr, int cc, float val) { RB(2)[rr * 68 + cc] = cc < rr ? val : 0.f; });
    mm16<4, 4>(tid, [&](f32x4* acc, const int* ii, const int* jj, int kq) { MMK(64, RB(4)[i * 68 + k], RB(7)[j * 68 + k]) },
               [&](int rr, int cc, float val) { RB(3)[rr * 68 + cc] = cc < rr ? val : 0.f; });
    __syncthreads();
    mm16<4, 4>(tid, [&](f32x4* acc, const int* ii, const int* jj, int kq) { MMK(64, RB(3)[i * 68 + k], RB(1)[k * 68 + j]) },
               [&](int rr, int cc, float val) { RB(0)[rr * 68 + cc] = val; });
    __syncthreads();
    mm16<4, 4>(tid, [&](f32x4* acc, const int* ii, const int* jj, int kq) { MMK(64, RB(5)[i * 68 + k], RB(6)[j * 68 + k]) },
               [&](int rr, int cc, float val) { RB(3)[rr * 68 + cc] = cc <= rr ? val : 0.f; });
    float* TI = GL + 64;
    if (tid < 64) {
      const int d = tid >> 4, cdx = tid & 15;
      const float* Ld = RB(2) + (d * 16) * 68 + d * 16;
      float x[16];
#pragma unroll
      for (int r = 0; r < 16; ++r) {
        float a = (r == cdx) ? 1.f : 0.f;
#pragma unroll
        for (int s2 = 0; s2 < r; ++s2) a = fmaf(Ld[r * 68 + s2], x[s2], a);
        x[r] = a;
        TI[(d * 16 + r) * 16 + cdx] = a;
      }
    }
    __syncthreads();
    {
      const int wv = tid >> 6, ln = tid & 63, li = ln & 15, kq = ln >> 4;
      float* slab = (wv < 4 ? RB(4) : RB(0)) + (wv & 3) * 16;
      const float* Lm = RB(2);
#pragma unroll
      for (int i = 0; i < 4; ++i) {
        f32x4 acc;
#pragma unroll
        for (int r = 0; r < 4; ++r) acc[r] = slab[(16 * i + 4 * kq + r) * 68 + li];
#pragma unroll
        for (int kb = 0; kb < i; ++kb)
#pragma unroll
          for (int st = 0; st < 4; ++st) {
            const int k = kb * 16 + 4 * kq + st;
            acc = __builtin_amdgcn_mfma_f32_16x16x4f32(Lm[(16 * i + li) * 68 + k], slab[k * 68 + li], acc, 0, 0, 0);
          }
#pragma unroll
        for (int r = 0; r < 4; ++r) slab[(16 * i + 4 * kq + r) * 68 + li] = acc[r];
        asm volatile("s_waitcnt lgkmcnt(0)" ::: "memory");
        __builtin_amdgcn_wave_barrier();
        f32x4 xo = {0.f, 0.f, 0.f, 0.f};
#pragma unroll
        for (int st = 0; st < 4; ++st) {
          const int k = 4 * kq + st;
          xo = __builtin_amdgcn_mfma_f32_16x16x4f32(TI[(i * 16 + li) * 16 + k], slab[(16 * i + k) * 68 + li], xo, 0, 0, 0);
        }
        asm volatile("s_waitcnt lgkmcnt(0)" ::: "memory");
        __builtin_amdgcn_wave_barrier();
#pragma unroll
        for (int r = 0; r < 4; ++r) slab[(16 * i + 4 * kq + r) * 68 + li] = xo[r];
        asm volatile("s_waitcnt lgkmcnt(0)" ::: "memory");
        __builtin_amdgcn_wave_barrier();
      }
    }
    __syncthreads();
    {
      float* Pt = Pg + (size_t)task * 4096;
      float* Dt = Dg + (size_t)task * 4096;
      bf16* Qt = QEg + (size_t)task * 4096;
      mm16<4, 4>(tid, [&](f32x4* acc, const int* ii, const int* jj, int kq) { MMK(64, RB(4)[k * 68 + i], RB(6)[k * 68 + j]) },
                 [&](int rr, int cc, float val) { Pt[rr * 64 + cc] = GL[cc] * val + (rr == cc ? GL[rr] : 0.f); });
      mm16<4, 4>(tid, [&](f32x4* acc, const int* ii, const int* jj, int kq) { MMK(64, RB(0)[k * 68 + i], RB(6)[k * 68 + j]) MMK(64, RB(1)[k * 68 + i], RB(7)[k * 68 + j]) },
                 [&](int rr, int cc, float val) { Dt[rr * 64 + cc] = GL[cc] * val; });
      mm16<4, 4>(tid, [&](f32x4* acc, const int* ii, const int* jj, int kq) { MMK(64, RB(5)[i * 68 + k], RB(7)[j * 68 + k]) },
                 [&](int rr, int cc, float val) { RB(2)[rr * 68 + cc] = cc <= rr ? val : 0.f; });
      mm16<4, 4>(tid, [&](f32x4* acc, const int* ii, const int* jj, int kq) { MMK(64, RB(3)[i * 68 + k], RB(4)[k * 68 + j]) },
                 [&](int rr, int cc, float val) { store_bf16_at(Qt + rr * 64 + cc, RB(5)[rr * 68 + cc] + val); });
    }
    __syncthreads();
    bf16* XGb = reinterpret_cast<bf16*>(RB(4));
    bf16* GUt = reinterpret_cast<bf16*>(RB(0));
    {
      bf16* Yt = YIg + (size_t)task * 4096;
      const float* gsrc = gup + (size_t)(tid >> 4) * 512 + hc + (tid & 15) * 4;
      const float4 gu0 = *reinterpret_cast<const float4*>(gsrc);
      const float4 gu1 = *reinterpret_cast<const float4*>(gsrc + 32 * 512);
      const float4 gu2 = *reinterpret_cast<const float4*>(gsrc + 64 * 512);
      const float4 gu3 = *reinterpret_cast<const float4*>(gsrc + 96 * 512);
      const float4 gu4 = *reinterpret_cast<const float4*>(gsrc + 128 * 512);
      for (int e = tid; e < 1280; e += 512) {
        const int t = e / 20, c8 = (e % 20) * 8; float x[8];
        lerp8(U, tok0 + t, (c * 64 + t) > 0, 1664 + c8, mu, x);
        uint4 pk;
        pk.x = cvt_pk_bf16(sigmoidf_(x[0]), sigmoidf_(x[1])); pk.y = cvt_pk_bf16(sigmoidf_(x[2]), sigmoidf_(x[3]));
        pk.z = cvt_pk_bf16(sigmoidf_(x[4]), sigmoidf_(x[5])); pk.w = cvt_pk_bf16(sigmoidf_(x[6]), sigmoidf_(x[7]));
        *reinterpret_cast<uint4*>(XGb + t * 168 + c8) = pk;
      }
      mm16<4, 4>(tid, [&](f32x4* acc, const int* ii, const int* jj, int kq) { MMK(64, RB(3)[i * 68 + k], RB(0)[k * 68 + j]) MMK(64, RB(2)[i * 68 + k], RB(1)[k * 68 + j]) },
                 [&](int rr, int cc, float val) { store_bf16_at(Yt + rr * 64 + cc, val); });
      __syncthreads();
      {
        const int gk = tid >> 4, gj = (tid & 15) * 4;
        bf16* d = GUt + gj * 168 + gk;
        T4(d, 168, gu0, 0); T4(d, 168, gu1, 32); T4(d, 168, gu2, 64); T4(d, 168, gu3, 96); T4(d, 168, gu4, 128);
      }
    }
    __syncthreads();
    {
      bf16* Gt = GTg + (size_t)task * 4096;
      mmb<4, 4, 160>(tid, XGb, 168, GUt, 168, [&](int rr, int cc, float val) { store_bf16_at(Gt + rr * 64 + cc, val); });
    }
  }
}

__device__ __forceinline__ void ph_rwkv_b(KP P, int layer) {
  float* sm = reinterpret_cast<float*>(smem_raw);
  bf16* Qb = reinterpret_cast<bf16*>(sm);
  bf16* Sb = reinterpret_cast<bf16*>(sm + 4352);
  float* Ys = sm + 2 * 4352;
  const bf16* U = reinterpret_cast<const bf16*>(P->ws + OFF_U);
  const float* Sg = reinterpret_cast<const float*>(P->ws + OFF_RD);
  const bf16* YIg = reinterpret_cast<const bf16*>(P->ws + OFF_RYI);
  const bf16* QEg = reinterpret_cast<const bf16*>(P->ws + OFF_RQE);
  const bf16* GTg = reinterpret_cast<const bf16*>(P->ws + OFF_RGT);
  const float* BCg = reinterpret_cast<const float*>(P->ws + OFF_RBC);
  bf16* YRW = reinterpret_cast<bf16*>(P->ws + OFF_YRW);
  const float* mu = P->in[8] + (size_t)layer * 1824;
  const float* gn_g = P->in[17] + (size_t)layer * 512;
  const float* gn_b = P->in[18] + (size_t)layer * 512;
  PHASE_TID
  const int et = tid >> 3, en = (tid & 7) * 8;
  uint4 nq, nyi, ngt, nvc, nvp; float4 ns0, ns1; float nbc;
#define RWB_LOAD(T) do { const int c_ = (T) & 127, h_ = ((T) >> 7) & 7, b_ = (T) >> 10; \
    const size_t tk_ = (size_t)b_ * SEQ + c_ * 64 + et; const size_t o_ = (size_t)(T) * 4096 + et * 64 + en; \
    nq = *reinterpret_cast<const uint4*>(QEg + o_); nyi = *reinterpret_cast<const uint4*>(YIg + o_); ngt = *reinterpret_cast<const uint4*>(GTg + o_); \
    nvc = *reinterpret_cast<const uint4*>(U + tk_ * LDU + 1024 + h_ * 64 + en); \
    nvp = (c_ * 64 + et) > 0 ? *reinterpret_cast<const uint4*>(U + (tk_ - 1) * LDU + 1024 + h_ * 64 + en) : make_uint4(0, 0, 0, 0); \
    ns0 = *reinterpret_cast<const float4*>(Sg + o_); ns1 = *reinterpret_cast<const float4*>(Sg + o_ + 4); nbc = BCg[(size_t)(T) * 64 + et]; } while (0)
  if (bid < 4096) RWB_LOAD(bid);
  for (int task = bid; task < 4096; task += GRID) {
    const int c = task & 127, h = (task >> 7) & 7, b = task >> 10;
    const size_t tok0 = (size_t)b * SEQ + c * 64;
    const int hc = h * 64;
    float yi[8], gt[8], v[8];
    const uint4 qraw = nq;
    {
      float vc[8], vp[8];
      unpack8(nyi, yi); unpack8(ngt, gt); unpack8(nvc, vc); unpack8(nvp, vp);
      const float4 m0 = *reinterpret_cast<const float4*>(mu + 1024 + hc + en), m1 = *reinterpret_cast<const float4*>(mu + 1024 + hc + en + 4);
      const float mm[8] = {m0.x, m0.y, m0.z, m0.w, m1.x, m1.y, m1.z, m1.w};
#pragma unroll
      for (int j = 0; j < 8; ++j) v[j] = vc[j] + (vp[j] - vc[j]) * mm[j];
    }
    const float4 s0 = ns0, s1 = ns1;
    const float bc = nbc;
    if (task + GRID < 4096) RWB_LOAD(task + GRID);
    __syncthreads();
    *reinterpret_cast<uint4*>(Qb + et * 72 + en) = qraw;
    { uint4 sp; sp.x = cvt_pk_bf16(s0.x, s0.y); sp.y = cvt_pk_bf16(s0.z, s0.w); sp.z = cvt_pk_bf16(s1.x, s1.y); sp.w = cvt_pk_bf16(s1.z, s1.w);
      *reinterpret_cast<uint4*>(Sb + et * 72 + en) = sp; }
    __syncthreads();
    mmb<4, 4, 64>(tid, Qb, 72, Sb, 72, [&](int rr, int cc, float val) { Ys[rr * 68 + cc] = val; });
    __syncthreads();
    {
      float y[8], s = 0.f;
#pragma unroll
      for (int j = 0; j < 8; ++j) { y[j] = Ys[et * 68 + en + j] + yi[j]; s += y[j]; }
      s += __shfl_xor(s, 1); s += __shfl_xor(s, 2); s += __shfl_xor(s, 4);
      const float mean = s * (1.f / 64.f);
      float s2 = 0.f;
#pragma unroll
      for (int j = 0; j < 8; ++j) { y[j] -= mean; s2 += y[j] * y[j]; }
      s2 += __shfl_xor(s2, 1); s2 += __shfl_xor(s2, 2); s2 += __shfl_xor(s2, 4);
      const float rstd = rsqrtf(s2 * (1.f / 64.f) + 64e-5f);
      float o[8];
#pragma unroll
      for (int j = 0; j < 8; ++j) {
        const int n = en + j;
        o[j] = (y[j] * rstd * gn_g[hc + n] + gn_b[hc + n] + bc * v[j]) * gt[j];
      }
      bf16* dst = YRW + (tok0 + et) * 512 + hc + en;
      store4bf(dst, o[0], o[1], o[2], o[3]); store4bf(dst + 4, o[4], o[5], o[6], o[7]);
    }
  }
}

__device__ __forceinline__ void ph_rwkv_scan(KP P, int layer) {
  float* Ss = reinterpret_cast<float*>(smem_raw);
  const float* Pg = reinterpret_cast<const float*>(P->ws + OFF_RP);
  float* Dg = reinterpret_cast<float*>(P->ws + OFF_RD);
  PHASE_TID
  const int wave = tid >> 6, lane = tid & 63, li = lane & 15, kq = lane >> 4;
  if (bid >= 128) {
    bf16* W = reinterpret_cast<bf16*>(P->ws + OFF_W);
    const size_t l = layer;
    const int cb = bid - 128;
    conv_mat(tid, cb, P->in[25] + l * DM * DFF, DFF, 0, DFF, DM, W + W_F2GU, 1, 128);
    conv_mat(tid, cb, P->in[26] + l * DM * DFF, DFF, 0, DFF, DM, W + W_F2GU, 2, 128);
    conv_mat(tid, cb, P->in[27] + l * DFF * DM, DM, 0, DM, DFF, W + W_F2D, 0, 128);
    if (layer < 3) {
      conv_mat(tid, cb, P->in[4] + (l + 1) * DM * DFF, DFF, 0, DFF, DM, W + W_F1GU, 1, 128);
      conv_mat(tid, cb, P->in[5] + (l + 1) * DM * DFF, DFF, 0, DFF, DM, W + W_F1GU, 2, 128);
      conv_mat(tid, cb, P->in[6] + (l + 1) * DFF * DM, DM, 0, DM, DFF, W + W_F1D, 0, 128);
    }
  }
  for (int task = bid; task < 128; task += GRID) {
    const int bh = task >> 2, rt = task & 3;
    __syncthreads();
    for (int e = tid; e < 16 * 68; e += 512) Ss[e] = 0.f;
    __syncthreads();
    if (wave < 4) {
      const int ct = wave;
      f32x4 sreg = {0.f, 0.f, 0.f, 0.f};
      float pn[16]; f32x4 dn;
      {
        const float* Pc = Pg + (size_t)(bh * 128) * 4096; const float* Dc = Dg + (size_t)(bh * 128) * 4096;
#pragma unroll
        for (int q = 0; q < 16; ++q) pn[q] = Pc[(q * 4 + kq) * 64 + ct * 16 + li];
#pragma unroll
        for (int r = 0; r < 4; ++r) dn[r] = Dc[(rt * 16 + kq * 4 + r) * 64 + ct * 16 + li];
      }
      for (int c = 0; c < 128; ++c) {
        float pc[16]; f32x4 acc0 = dn, acc1 = {0.f, 0.f, 0.f, 0.f};
#pragma unroll
        for (int q = 0; q < 16; ++q) pc[q] = pn[q];
        float* So = Dg + (size_t)(bh * 128 + c) * 4096;
#pragma unroll
        for (int r = 0; r < 4; ++r) So[(rt * 16 + kq * 4 + r) * 64 + ct * 16 + li] = sreg[r];
        if (c + 1 < 128) {
          const float* Pc = Pg + (size_t)(bh * 128 + c + 1) * 4096; const float* Dc = Dg + (size_t)(bh * 128 + c + 1) * 4096;
#pragma unroll
          for (int q = 0; q < 16; ++q) pn[q] = Pc[(q * 4 + kq) * 64 + ct * 16 + li];
#pragma unroll
          for (int r = 0; r < 4; ++r) dn[r] = Dc[(rt * 16 + kq * 4 + r) * 64 + ct * 16 + li];
        }
#pragma unroll
        for (int q = 0; q < 16; q += 2) {
          acc0 = __builtin_amdgcn_mfma_f32_16x16x4f32(Ss[li * 68 + q * 4 + kq], pc[q], acc0, 0, 0, 0);
          acc1 = __builtin_amdgcn_mfma_f32_16x16x4f32(Ss[li * 68 + (q + 1) * 4 + kq], pc[q + 1], acc1, 0, 0, 0);
        }
        sreg = acc0 + acc1;
        asm volatile("s_waitcnt lgkmcnt(0)" ::: "memory");
        __builtin_amdgcn_s_barrier();
#pragma unroll
        for (int r = 0; r < 4; ++r) Ss[(kq * 4 + r) * 68 + ct * 16 + li] = sreg[r];
        asm volatile("s_waitcnt lgkmcnt(0)" ::: "memory");
        __builtin_amdgcn_s_barrier();
      }
    } else {
      for (int c = 0; c < 128; ++c) { __builtin_amdgcn_s_barrier(); __builtin_amdgcn_s_barrier(); }
    }
  }
}

__device__ __forceinline__ void hg_lb_setup(const int tid, KP P, int layer, float* LB) {
  const float* raw = P->in[19];
  for (int ch = tid; ch < 512; ch += 512) {
    const float r0 = raw[ch], r1 = raw[512 + ch], r2 = raw[1024 + ch], r3 = raw[1536 + ch];
    const float mx = fmaxf(fmaxf(r0, r1), fmaxf(r2, r3));
    const float e0 = expf(r0 - mx), e1 = expf(r1 - mx), e2 = expf(r2 - mx), e3 = expf(r3 - mx);
    const float inv = 1.f / (e0 + e1 + e2 + e3);
    float lb = 0.f;
    if (layer >= 1) lb += e1 * inv;
    if (layer >= 2) lb += e2 * inv;
    if (layer >= 3) lb += e3 * inv;
    LB[ch] = lb;
  }
}
__device__ __forceinline__ void hg_fk(const float* x, const float* lb, float* lf, float* kk) {
#pragma unroll
  for (int j = 0; j < 8; ++j) {
    const float e = __expf(-fabsf(x[j]));
    const float rc = 1.f / (1.f + e);
    const float sp = x[j] >= 0.f ? rc : e * rc;
    const float sn = x[j] >= 0.f ? e * rc : rc;
    const float f = lb[j] + (1.f - lb[j]) * sp;
    lf[j] = __logf(f);
    kk[j] = (1.f - lb[j]) * sn;
  }
}
__device__ __forceinline__ void hg_cumsum(const int tid, float* G, float* ST, const float scale) {
  const int k = tid & 127, seg = tid >> 7;
  float run = 0.f;
#pragma unroll
  for (int t = 0; t < 16; ++t) { run += G[(seg * 16 + t) * 132 + k]; G[(seg * 16 + t) * 132 + k] = run; }
  ST[seg * 128 + k] = run;
  __syncthreads();
  float off = 0.f;
  if (seg > 0) off += ST[k];
  if (seg > 1) off += ST[128 + k];
  if (seg > 2) off += ST[256 + k];
#pragma unroll
  for (int t = 0; t < 16; ++t) { const int o = (seg * 16 + t) * 132 + k; G[o] = (G[o] + off) * scale; }
  __syncthreads();
}

__device__ __forceinline__ void ph_hg1(KP P, int layer) {
  float* G = reinterpret_cast<float*>(smem_raw);
  float* KK = G + 8448;
  bf16* KDt = reinterpret_cast<bf16*>(KK + 8448);
  bf16* Vt = KDt + 128 * 72;
  float* ST = reinterpret_cast<float*>(Vt + 128 * 72);
  float* LB = ST + 512;
  const bf16* U = reinterpret_cast<const bf16*>(P->ws + OFF_U);
  bf16* Dg = reinterpret_cast<bf16*>(P->ws + OFF_HD);
  float* Gg = reinterpret_cast<float*>(P->ws + OFF_HG);
  PHASE_TID
  __syncthreads();
  hg_lb_setup(tid, P, layer, LB);
  uint4 nf0, nf1, nv0, nv1;
#define HG1_LOAD(T) do { const int c_ = (T) & 127, h_ = ((T) >> 7) & 3, b_ = (T) >> 9; const size_t tk_ = (size_t)b_ * SEQ + c_ * 64; \
    nf0 = *reinterpret_cast<const uint4*>(U + (tk_ + (tid >> 4)) * LDU + 512 + h_ * 128 + (tid & 15) * 8); \
    nf1 = *reinterpret_cast<const uint4*>(U + (tk_ + 32 + (tid >> 4)) * LDU + 512 + h_ * 128 + (tid & 15) * 8); \
    nv0 = *reinterpret_cast<const uint4*>(U + (tk_ + (tid & 63)) * LDU + 1024 + h_ * 128 + (tid >> 6) * 8); \
    nv1 = *reinterpret_cast<const uint4*>(U + (tk_ + (tid & 63)) * LDU + 1024 + h_ * 128 + (8 + (tid >> 6)) * 8); } while (0)
  if (bid < 2048) HG1_LOAD(bid);
  for (int task = bid; task < 2048; task += GRID) {
    const int h = (task >> 7) & 3;
    const uint4 f0 = nf0, f1 = nf1, v0 = nv0, v1 = nv1;
    __syncthreads();
    if (task + GRID < 2048) HG1_LOAD(task + GRID);
    {
      float x[8], lf[8], kk[8];
      { const int t = tid >> 4, k8 = (tid & 15) * 8;
        unpack8(f0, x); hg_fk(x, LB + h * 128 + k8, lf, kk);
#pragma unroll
        for (int j = 0; j < 8; ++j) { G[t * 132 + k8 + j] = lf[j]; KK[t * 132 + k8 + j] = kk[j]; } }
      { const int t = 32 + (tid >> 4), k8 = (tid & 15) * 8;
        unpack8(f1, x); hg_fk(x, LB + h * 128 + k8, lf, kk);
#pragma unroll
        for (int j = 0; j < 8; ++j) { G[t * 132 + k8 + j] = lf[j]; KK[t * 132 + k8 + j] = kk[j]; } }
      scatter8(v0, reinterpret_cast<unsigned short*>(Vt) + ((tid >> 6) * 8) * 72 + (tid & 63), 72);
      scatter8(v1, reinterpret_cast<unsigned short*>(Vt) + ((8 + (tid >> 6)) * 8) * 72 + (tid & 63), 72);
    }
    __syncthreads();
    hg_cumsum(tid, G, ST, 1.f);
    if (tid < 128) Gg[(size_t)task * 128 + tid] = __expf(G[63 * 132 + tid]);
#pragma unroll 4
    for (int i = 0; i < 16; ++i) {
      const int e = tid + 512 * i, s = e & 63, k = e >> 6;
      KDt[k * 72 + s] = __float2bfloat16(KK[s * 132 + k] * __expf(G[63 * 132 + k] - G[s * 132 + k]));
    }
    __syncthreads();
    bf16* Dt = Dg + (size_t)task * 16384;
    mmb<8, 8, 64>(tid, Vt, 72, KDt, 72, [&](int r, int cc, float v) { Dt[r * 128 + cc] = __float2bfloat16(v); });
  }
}
__device__ __forceinline__ void ph_hg2(KP P) {
  const unsigned short* Dg = reinterpret_cast<const unsigned short*>(P->ws + OFF_HD);
  const float* Gg = reinterpret_cast<const float*>(P->ws + OFF_HG);
  bf16* Sg = reinterpret_cast<bf16*>(P->ws + OFF_HS);
  PHASE_TID
  for (int e = bid * 512 + tid; e < 16 * 16384; e += GRID * 512) {
    const int bh = e >> 14, vk = e & 16383, k = vk & 127;
    float S = 0.f;
#pragma unroll 8
    for (int c = 0; c < 128; ++c) {
      const size_t t = (size_t)bh * 128 + c;
      const float d = __uint_as_float((unsigned)Dg[t * 16384 + vk] << 16), g = Gg[t * 128 + k];
      Sg[t * 16384 + vk] = __float2bfloat16(S);
      S = g * S + d;
    }
  }
}
__device__ __forceinline__ void ph_hg3(KP P, int layer) {
  float* Q = reinterpret_cast<float*>(smem_raw);
  float* KK = Q + 8448;
  float* G2 = KK + 8448;
  bf16* Ab = reinterpret_cast<bf16*>(G2 + 8448);
  bf16* Vt = Ab + 64 * 72;
  bf16* QEb = Vt + 128 * 72;
  float* ST = reinterpret_cast<float*>(QEb + 64 * 136);
  float* LB = ST + 512;
  bf16* SINt = reinterpret_cast<bf16*>(KK);
  const bf16* U = reinterpret_cast<const bf16*>(P->ws + OFF_U);
  const bf16* Sg = reinterpret_cast<const bf16*>(P->ws + OFF_HS);
  bf16* YHG = reinterpret_cast<bf16*>(P->ws + OFF_YHG);
  const float* norm_g = P->in[20] + (size_t)layer * 512;
  PHASE_TID
  const int wave = tid >> 6, lane = tid & 63, li = lane & 15, kq = lane >> 4;
  __syncthreads();
  hg_lb_setup(tid, P, layer, LB);
  for (int task = bid; task < 2048; task += GRID) {
    const int c = task & 127, h = (task >> 7) & 3, b = task >> 9;
    const size_t tok0 = (size_t)b * SEQ + c * 64;
    __syncthreads();
#pragma unroll
    for (int i = 0; i < 2; ++i) {
      const int e = tid + 512 * i;
      { const int t = e >> 4, k8 = (e & 15) * 8;
        float x[8], lf[8], kk[8], q[8];
        load8(U + (tok0 + t) * LDU + 512 + h * 128 + k8, x);
        hg_fk(x, LB + h * 128 + k8, lf, kk);
        load8(U + (tok0 + t) * LDU + h * 128 + k8, q);
#pragma unroll
        for (int j = 0; j < 8; ++j) { const int o = t * 132 + k8 + j; G2[o] = lf[j]; KK[o] = kk[j]; Q[o] = sigmoidf_(q[j]); } }
    }
    const uint4 vr0 = *reinterpret_cast<const uint4*>(U + (tok0 + (tid & 63)) * LDU + 1024 + h * 128 + (tid >> 6) * 8);
    const uint4 vr1 = *reinterpret_cast<const uint4*>(U + (tok0 + (tid & 63)) * LDU + 1024 + h * 128 + ((tid + 512) >> 6) * 8);
    __syncthreads();
    hg_cumsum(tid, G2, ST, 1.4426950408889634f);
    bf16* X1 = QEb;
    bf16* X2 = Vt;
    for (int e = tid; e < 1536; e += 512) {
      const int blk = e >> 8, r = (e >> 4) & 15, cc = e & 15;
      const int bi = blk < 3 ? 0 : (blk < 5 ? 1 : 2), bj = blk < 3 ? blk + 1 : (blk < 5 ? blk - 1 : 3);
      Ab[(bi * 16 + r) * 72 + bj * 16 + cc] = __float2bfloat16(0.f);
    }
    for (int i = 0; i < 2; ++i) {
      const int t0 = (wave * 2 + i) * 4, t = t0 + (lane >> 4), s = (t0 & ~15) + (lane & 15);
      float a = 0.f;
      const float4* qt = reinterpret_cast<const float4*>(Q + t * 132);
      const float4* gt = reinterpret_cast<const float4*>(G2 + t * 132);
      const float4* ks = reinterpret_cast<const float4*>(KK + s * 132);
      const float4* gs = reinterpret_cast<const float4*>(G2 + s * 132);
#pragma unroll 4
      for (int k4 = 0; k4 < 32; ++k4) {
        const float4 q4 = qt[k4], g4 = gt[k4], k4v = ks[k4], h4 = gs[k4];
        a = fmaf(q4.x * k4v.x, exp2f(fminf(g4.x - h4.x, 0.f)), a);
        a = fmaf(q4.y * k4v.y, exp2f(fminf(g4.y - h4.y, 0.f)), a);
        a = fmaf(q4.z * k4v.z, exp2f(fminf(g4.z - h4.z, 0.f)), a);
        a = fmaf(q4.w * k4v.w, exp2f(fminf(g4.w - h4.w, 0.f)), a);
      }
      Ab[t * 72 + s] = __float2bfloat16(s <= t ? a : 0.f);
    }
#pragma unroll 2
    for (int i = 0; i < 8; ++i) {
      const int e = tid + 512 * i, t = e >> 6, k2 = (e & 63) * 2;
      const float g0 = G2[t * 132 + k2], g1 = G2[t * 132 + k2 + 1];
      {
        const float r0 = G2[31 * 132 + k2], r1 = G2[31 * 132 + k2 + 1];
        float x0, x1;
        if (t < 32) { x0 = KK[t * 132 + k2] * exp2f(fminf(r0 - g0, 0.f)); x1 = KK[t * 132 + k2 + 1] * exp2f(fminf(r1 - g1, 0.f)); }
        else { x0 = Q[t * 132 + k2] * exp2f(fminf(g0 - r0, 0.f)); x1 = Q[t * 132 + k2 + 1] * exp2f(fminf(g1 - r1, 0.f)); }
        *reinterpret_cast<unsigned*>(X1 + t * 136 + k2) = cvt_pk_bf16(x0, x1);
      }
      {
        const int rb = (t < 32) ? 15 : 47;
        const float r0 = G2[rb * 132 + k2], r1 = G2[rb * 132 + k2 + 1];
        float x0, x1;
        if ((t & 31) < 16) { x0 = KK[t * 132 + k2] * exp2f(fminf(r0 - g0, 0.f)); x1 = KK[t * 132 + k2 + 1] * exp2f(fminf(r1 - g1, 0.f)); }
        else { x0 = Q[t * 132 + k2] * exp2f(fminf(g0 - r0, 0.f)); x1 = Q[t * 132 + k2 + 1] * exp2f(fminf(g1 - r1, 0.f)); }
        *reinterpret_cast<unsigned*>(X2 + t * 136 + k2) = cvt_pk_bf16(x0, x1);
      }
    }
    __syncthreads();
    if (wave < 6) {
      const bf16* Xs = wave < 4 ? X1 : X2;
      const int arow = wave < 4 ? 32 + (wave >> 1) * 16 : (wave == 4 ? 16 : 48);
      const int brow = wave < 4 ? (wave & 1) * 16 : (wave == 4 ? 0 : 32);
      f32x4 acc = {0.f, 0.f, 0.f, 0.f};
      const bf16* ap = Xs + (arow + li) * 136 + kq * 8;
      const bf16* bp = Xs + (brow + li) * 136 + kq * 8;
#pragma unroll
      for (int kk = 0; kk < 128; kk += 32)
        acc = __builtin_amdgcn_mfma_f32_16x16x32_bf16(*reinterpret_cast<const bf16x8*>(ap + kk), *reinterpret_cast<const bf16x8*>(bp + kk), acc, 0, 0, 0);
#pragma unroll
      for (int r = 0; r < 4; ++r) Ab[(arow + kq * 4 + r) * 72 + brow + li] = __float2bfloat16(acc[r]);
    }
    __syncthreads();
#pragma unroll 4
    for (int i = 0; i < 8; ++i) {
      const int e = tid + 512 * i, t = e >> 6, k2 = (e & 63) * 2;
      const float q0 = Q[t * 132 + k2] * exp2f(G2[t * 132 + k2]), q1 = Q[t * 132 + k2 + 1] * exp2f(G2[t * 132 + k2 + 1]);
      *reinterpret_cast<unsigned*>(QEb + t * 136 + k2) = cvt_pk_bf16(q0, q1);
    }
    scatter8(vr0, reinterpret_cast<unsigned short*>(Vt) + ((tid >> 6) * 8) * 72 + (tid & 63), 72);
    scatter8(vr1, reinterpret_cast<unsigned short*>(Vt) + (((tid + 512) >> 6) * 8) * 72 + (tid & 63), 72);
    __syncthreads();
    { const bf16* St = Sg + (size_t)task * 16384;
#pragma unroll
      for (int i = 0; i < 4; ++i) {
        const int e = tid + 512 * i, r = e >> 4, c8 = (e & 15) * 8;
        *reinterpret_cast<uint4*>(SINt + r * 136 + c8) = *reinterpret_cast<const uint4*>(St + r * 128 + c8);
      } }
    __syncthreads();
    f32x4 o[4];
    const int rt = wave & 3, cb = (wave >> 2) * 64;
    {
#pragma unroll
      for (int cc = 0; cc < 4; ++cc) o[cc] = f32x4{0.f, 0.f, 0.f, 0.f};
      const bf16* ap = Ab + (rt * 16 + li) * 72 + kq * 8;
#pragma unroll
      for (int kk = 0; kk < 64; kk += 32) {
        const bf16x8 a = *reinterpret_cast<const bf16x8*>(ap + kk);
#pragma unroll
        for (int cc = 0; cc < 4; ++cc)
          o[cc] = __builtin_amdgcn_mfma_f32_16x16x32_bf16(a, *reinterpret_cast<const bf16x8*>(Vt + (cb + cc * 16 + li) * 72 + kq * 8 + kk), o[cc], 0, 0, 0);
      }
      const bf16* qp = QEb + (rt * 16 + li) * 136 + kq * 8;
#pragma unroll
      for (int kk = 0; kk < 128; kk += 32) {
        const bf16x8 a = *reinterpret_cast<const bf16x8*>(qp + kk);
#pragma unroll
        for (int cc = 0; cc < 4; ++cc)
          o[cc] = __builtin_amdgcn_mfma_f32_16x16x32_bf16(a, *reinterpret_cast<const bf16x8*>(SINt + (cb + cc * 16 + li) * 136 + kq * 8 + kk), o[cc], 0, 0, 0);
      }
    }
#pragma unroll
    for (int cc = 0; cc < 4; ++cc)
#pragma unroll
      for (int r = 0; r < 4; ++r) Q[(rt * 16 + kq * 4 + r) * 132 + cb + cc * 16 + li] = o[cc][r];
    __syncthreads();
    {
      const int t = tid >> 3, v0 = (tid & 7) * 16;
      float y[16], ss = 0.f;
#pragma unroll
      for (int j = 0; j < 16; ++j) { y[j] = Q[t * 132 + v0 + j]; ss += y[j] * y[j]; }
      ss += __shfl_xor(ss, 1); ss += __shfl_xor(ss, 2); ss += __shfl_xor(ss, 4);
      const float sc = rsqrtf(ss * (1.f / 128.f) + 1e-5f);
      float og[16];
      load8(U + (tok0 + t) * LDU + 1536 + h * 128 + v0, og);
      load8(U + (tok0 + t) * LDU + 1536 + h * 128 + v0 + 8, og + 8);
      float r[16];
#pragma unroll
      for (int j = 0; j < 16; ++j) r[j] = y[j] * sc * norm_g[h * 128 + v0 + j] * (og[j] * sigmoidf_(og[j]));
      bf16* dst = YHG + (tok0 + t) * 512 + h * 128 + v0;
      store4bf(dst, r[0], r[1], r[2], r[3]); store4bf(dst + 4, r[4], r[5], r[6], r[7]);
      store4bf(dst + 8, r[8], r[9], r[10], r[11]); store4bf(dst + 12, r[12], r[13], r[14], r[15]);
    }
  }
}

#define KPL ({ KP q_ = kp0; asm volatile("" : "+s"(q_)); q_; })
#define WS_(T, off) reinterpret_cast<T*>(kp->ws + (off))
#define GSYNC() do { KP kpb_ = KPL; xcd_barrier(kpb_); } while (0)
__device__ __forceinline__ void layer_body(const KP kp0, const int layer_) {
  {
    int layer = layer_;
    asm volatile("" : "+s"(layer));
    { KP kp = KPL; ph_convert(kp, layer, layer == 0); }
    if (layer_ == 0) GSYNC(); else __syncthreads();
    { KP kp = KPL; ph_ffn_a(WS_(bf16, OFF_H16), WS_(bf16, OFF_W) + W_F1GU, WS_(bf16, OFF_ACT)); }
    GSYNC();
    { KP kp = KPL; if (layer_ == 0) ph_res<false>(WS_(bf16, OFF_ACT), WS_(bf16, OFF_W) + W_F1D, DFF, WS_(float, OFF_H32), 0.5f, WS_(float2, OFF_STATS), kp->in[2], kp->in[3], kp->in[0]); else ph_res<true>(WS_(bf16, OFF_ACT), WS_(bf16, OFF_W) + W_F1D, DFF, WS_(float, OFF_H32), 0.5f, WS_(float2, OFF_STATS), kp->in[2] + (size_t)(layer * 4 - 1) * DM, kp->in[3] + (size_t)(layer * 4 - 1) * DM); }
    GSYNC();
    { KP kp = KPL; ph_ln(WS_(float, OFF_H32), WS_(bf16, OFF_H16), kp->in[2] + (size_t)layer * 4 * DM, kp->in[3] + (size_t)layer * 4 * DM, nullptr, WS_(float2, OFF_STATS)); }
    GSYNC();
    { KP kp = KPL; ph_proj<false>(WS_(bf16, OFF_H16), WS_(bf16, OFF_W) + W_SB, 1536, DM, WS_(bf16, OFF_U), LDU); }
    GSYNC();
    { KP kp = KPL; ph_sb(WS_(bf16, OFF_U), WS_(bf16, OFF_YSB)); }
    GSYNC();
    { KP kp = KPL; ph_proj<false>(WS_(bf16, OFF_H16), WS_(bf16, OFF_W) + W_RW, 2048, DM, WS_(bf16, OFF_U), LDU); }
    GSYNC();
    { KP kp = KPL; ph_rwkv_a(kp, layer); }
    GSYNC();
    { KP kp = KPL; ph_rwkv_scan(kp, layer); }
    GSYNC();
    { KP kp = KPL; ph_rwkv_b(kp, layer); }
    GSYNC();
    { KP kp = KPL; ph_proj<false>(WS_(bf16, OFF_H16), WS_(bf16, OFF_W) + W_HG, 2048, DM, WS_(bf16, OFF_U), LDU); }
    GSYNC();
    { KP kp = KPL; ph_hg1(kp, layer); }
    GSYNC();
    { KP kp = KPL; ph_hg2(kp); }
    GSYNC();
    { KP kp = KPL; ph_hg3(kp, layer); }
    GSYNC();
    { KP kp = KPL; ph_proj<true>(WS_(bf16, OFF_H16), WS_(bf16, OFF_W) + W_GATE, 3072, DM, WS_(bf16, OFF_GATE), 3072); }
    GSYNC();
    { KP kp = KPL; ph_merge(WS_(bf16, OFF_YRW), WS_(bf16, OFF_YSB), WS_(bf16, OFF_YHG), WS_(bf16, OFF_W) + W_BR, WS_(bf16, OFF_GATE), WS_(float, OFF_M32), WS_(bf16, OFF_H16)); }
    GSYNC();
    { KP kp = KPL; ph_res<true>(WS_(bf16, OFF_H16), WS_(bf16, OFF_W) + W_OUT, DM, WS_(float, OFF_H32), 1.0f, WS_(float2, OFF_STATS), kp->in[2] + (size_t)(layer * 4) * DM, kp->in[3] + (size_t)(layer * 4) * DM); }
    GSYNC();
    { KP kp = KPL; ph_ln(WS_(float, OFF_H32), WS_(bf16, OFF_H16), kp->in[2] + (size_t)(layer * 4 + 1) * DM, kp->in[3] + (size_t)(layer * 4 + 1) * DM, nullptr, WS_(float2, OFF_STATS)); }
    GSYNC();
    { KP kp = KPL; ph_ffn_a(WS_(bf16, OFF_H16), WS_(bf16, OFF_W) + W_F2GU, WS_(bf16, OFF_ACT)); }
    GSYNC();
    { KP kp = KPL; ph_res<true>(WS_(bf16, OFF_ACT), WS_(bf16, OFF_W) + W_F2D, DFF, WS_(float, OFF_H32), 0.5f, WS_(float2, OFF_STATS), kp->in[2] + (size_t)(layer * 4 + 1) * DM, kp->in[3] + (size_t)(layer * 4 + 1) * DM); }
    GSYNC();
    { KP kp = KPL; ph_ln(WS_(float, OFF_H32), WS_(bf16, OFF_H16), kp->in[2] + (size_t)(layer * 4 + 2) * DM, kp->in[3] + (size_t)(layer * 4 + 2) * DM, nullptr, WS_(float2, OFF_STATS)); ph_pconv(kp, layer); }
    GSYNC();
    { KP kp = KPL; ph_ple(WS_(bf16, OFF_H16), WS_(bf16, OFF_P16), WS_(bf16, OFF_W) + W_PG, WS_(bf16, OFF_W) + W_PP, WS_(float, OFF_M32), WS_(float, OFF_H32), WS_(float2, OFF_STATS), kp->in[2] + (size_t)(layer * 4 + 2) * DM, kp->in[3] + (size_t)(layer * 4 + 2) * DM); }
    GSYNC();
    { KP kp = KPL; ph_ln(WS_(float, OFF_H32), WS_(bf16, OFF_H16), kp->in[2] + (size_t)(layer * 4 + 3) * DM, kp->in[3] + (size_t)(layer * 4 + 3) * DM, layer == 3 ? kp->out : nullptr, WS_(float2, OFF_STATS)); }
    if (layer_ < 3) GSYNC();
  }
}
__global__ void __launch_bounds__(512) fwd_megakernel(Params Pval) {
  const KP kp0 = (KP)__builtin_amdgcn_kernarg_segment_ptr();
  {
    cg::grid_group grid = cg::this_grid();
    unsigned* bar = reinterpret_cast<unsigned*>(kp0->ws + OFF_BAR);
    if (blockIdx.x == 0) for (int i = threadIdx.x; i < XCD_BAR_WORDS; i += 512) __hip_atomic_store(&bar[i], 0u, __ATOMIC_RELAXED, __HIP_MEMORY_SCOPE_AGENT);
    if (threadIdx.x == 0) {
      volatile unsigned* st = reinterpret_cast<volatile unsigned*>(smem_raw + XB_LDS_OFF);
      st[0] = 0u; st[1] = 0u; st[2] = 0u; st[3] = 0u;
    }
    grid.sync();
    if (threadIdx.x == 0) (void)xb_add(&bar[XB_XCNT(xb_xcc_id())], 1u);
    __syncthreads();
  }
  layer_body(kp0, 0);
  layer_body(kp0, 1);
  layer_body(kp0, 2);
  layer_body(kp0, 3);
}

extern "C" void kernel_launch(void* const* d_in, const int* in_sizes, int n_in, void* d_out, int out_size, void* d_ws,
                              size_t ws_size, hipStream_t stream) {
  static int inited = 0;
  if (!inited) {
    (void)hipFuncSetAttribute((const void*)fwd_megakernel, hipFuncAttributeMaxDynamicSharedMemorySize, LDS_BYTES);
    inited = 1;
  }
  Params p{};
  for (int i = 0; i < 30; ++i) p.in[i] = (const float*)d_in[i];
  p.out = (float*)d_out;
  p.ws = (unsigned char*)d_ws;
  void* args[] = {&p};
  hipError_t e = hipLaunchCooperativeKernel((const void*)fwd_megakernel, dim3(256), dim3(512), args, LDS_BYTES, stream);
  if (e != hipSuccess) fprintf(stderr, "cooperative launch failed: %s\n", hipGetErrorString(e));
}
```

```cpp
#include <hip/hip_runtime.h>
#include <hip/hip_bf16.h>
#include <hip/hip_cooperative_groups.h>
#include <cstdio>
namespace cg = cooperative_groups;

typedef __hip_bfloat16 bf16;
using bf16x8 = __attribute__((ext_vector_type(8))) short;
using f32x4 = __attribute__((ext_vector_type(4))) float;

#define MTOK 32768
#define DM 1024
#define DFF 2816
#define SEQ 8192
#define LDU 2048
#define MIB ((size_t)1 << 20)
#define ALPHA_F 1.681792830507429f

#define OFF_H32 ((size_t)0)
#define OFF_H16 (128 * MIB)
#define OFF_W (192 * MIB)
#define OFF_R (250 * MIB)
#define OFF_P16 (OFF_R + 128 * MIB)
#define OFF_ACT (OFF_R)
#define OFF_U (OFF_R)
#define OFF_YRW (OFF_R + 128 * MIB)
#define OFF_YSB (OFF_R + 160 * MIB)
#define OFF_YHG (OFF_R + 192 * MIB)
#define OFF_SCR (OFF_R + 224 * MIB)
#define OFF_RP (OFF_SCR)
#define OFF_RD (OFF_SCR + 64 * MIB)
#define OFF_RYI (OFF_SCR + 128 * MIB)
#define OFF_RQE (OFF_SCR + 160 * MIB)
#define OFF_RGT (OFF_SCR + 192 * MIB)
#define OFF_RBC (OFF_SCR + 224 * MIB)
#define OFF_HD (OFF_SCR)
#define OFF_HS (OFF_SCR + 128 * MIB)
#define OFF_HG (OFF_SCR + 192 * MIB)
#define OFF_GATE (OFF_R + 224 * MIB)
#define OFF_M32 (OFF_R)
#define W_F1GU 0
#define W_F1D 5767168
#define W_F2GU 8650752
#define W_F2D 14417920
#define W_RW 17301504
#define W_SB 19398656
#define W_HG 20971520
#define W_GATE 23068672
#define W_BR 26214400
#define W_OUT 27787264
#define W_PG 28835840
#define W_PP 29884416

#define LDS_BYTES 155648
#define GRID 256
#define PHASE_TID int tid = threadIdx.x; asm volatile("" : "+v"(tid)); int bid = blockIdx.x; asm volatile("" : "+s"(bid));

struct Params {
  const float* in[30];
  float* out;
  unsigned char* ws;
};

typedef const __attribute__((address_space(4))) Params* KP;
extern __shared__ __attribute__((aligned(16))) unsigned char smem_raw[];


#define OFF_BAR (249 * MIB + 768 * 1024)
#define OFF_STATS (249 * MIB + 512 * 1024)
#define XB_TMO      128
#define XB_XCNT(j)  (256  + 64 * (j))
#define XB_XSUB(j)  (1280 + 64 * (j))
#define XB_XGEN(j)  (2304 + 64 * (j))
#define XB_TOP      3328
#define XB_TOPGEN   3392
#define XCD_BAR_WORDS 3456
#define XB_SPIN_CAP (1u << 22)
#define XB_LDS_OFF (LDS_BYTES - 16)
__device__ __forceinline__ unsigned xb_ld(unsigned* p) { return __hip_atomic_load(p, __ATOMIC_RELAXED, __HIP_MEMORY_SCOPE_AGENT); }
__device__ __forceinline__ unsigned xb_add(unsigned* p, unsigned v) { return __hip_atomic_fetch_add(p, v, __ATOMIC_RELAXED, __HIP_MEMORY_SCOPE_AGENT); }
__device__ __forceinline__ unsigned xb_xcc_id() { return (unsigned)__builtin_amdgcn_s_getreg((3 << 11) | 20) & 0xFu; }
#define XB_SPIN(cond, bar) do { unsigned _sp = 0; while (cond) { __builtin_amdgcn_s_sleep(1); \
    if ((++_sp & 255u) == 0u) { if (xb_ld(&(bar)[XB_TMO])) break; if (_sp > XB_SPIN_CAP) { atomicAdd(&(bar)[XB_TMO], 1u); break; } } } } while (0)
__device__ __forceinline__ void xcd_barrier_complete(unsigned* bar, unsigned x, unsigned& nloc, unsigned& nx) {
  const unsigned G = GRID;
  unsigned sum, cnt, mine, sp = 0u;
  for (;;) {
    sum = 0u; cnt = 0u; mine = 0u;
#pragma unroll
    for (unsigned j = 0; j < 16; ++j) { const unsigned c = xb_ld(&bar[XB_XCNT(j)]); sum += c; cnt += (c > 0u) ? 1u : 0u; mine = (j == x) ? c : mine; }
    if (sum == G) break;
    __builtin_amdgcn_s_sleep(1);
    if ((++sp & 255u) == 0u) { if (xb_ld(&bar[XB_TMO])) break; if (sp > XB_SPIN_CAP) { atomicAdd(&bar[XB_TMO], 1u); break; } }
  }
  nloc = mine > 0u ? mine : 1u; nx = cnt > 0u ? cnt : 1u;
}
__device__ __forceinline__ void xcd_barrier(KP kp) {
  asm volatile("s_waitcnt vmcnt(0)" ::: "memory");
  __syncthreads();
  if (threadIdx.x == 0) {
    unsigned* bar = reinterpret_cast<unsigned*>(kp->ws + OFF_BAR);
    volatile unsigned* st = reinterpret_cast<volatile unsigned*>(smem_raw + XB_LDS_OFF);
    const unsigned x = xb_xcc_id();
    __builtin_amdgcn_s_waitcnt(0);
    unsigned nloc = st[0], nx = st[1];
    if (nloc == 0u) { xcd_barrier_complete(bar, x, nloc, nx); st[0] = nloc; st[1] = nx; }
    const unsigned old = xb_add(&bar[XB_XSUB(x)], 1u);
    const unsigned gen = old / nloc;
    if (old + 1u == (gen + 1u) * nloc) {
      __builtin_amdgcn_fence(__ATOMIC_RELEASE, "agent");
      asm volatile("s_waitcnt vmcnt(0)" ::: "memory");
      const unsigned og = xb_add(&bar[XB_TOP], 1u);
      const unsigned tg = og / nx;
      if (og + 1u == (tg + 1u) * nx) xb_add(&bar[XB_TOPGEN], 1u);
      else XB_SPIN(xb_ld(&bar[XB_TOPGEN]) == tg, bar);
      __builtin_amdgcn_fence(__ATOMIC_ACQUIRE, "agent");
      xb_add(&bar[XB_XGEN(x)], 1u);
      asm volatile("s_waitcnt vmcnt(0)" ::: "memory");
    } else {
      XB_SPIN(xb_ld(&bar[XB_XGEN(x)]) == gen, bar);
      __builtin_amdgcn_fence(__ATOMIC_ACQUIRE, "agent");
      asm volatile("s_waitcnt vmcnt(0)" ::: "memory");
    }
  }
  __syncthreads();
}

__device__ __forceinline__ unsigned cvt_pk_bf16(float lo, float hi) {
  unsigned r;
  asm volatile("v_cvt_pk_bf16_f32 %0, %1, %2" : "=v"(r) : "v"(lo), "v"(hi));
  return r;
}
__device__ __forceinline__ float bf_lo(unsigned u) { return __uint_as_float(u << 16); }
__device__ __forceinline__ float bf_hi(unsigned u) { return __uint_as_float(u & 0xffff0000u); }
__device__ __forceinline__ void unpack8(const uint4& r, float* f) {
  f[0] = bf_lo(r.x); f[1] = bf_hi(r.x); f[2] = bf_lo(r.y); f[3] = bf_hi(r.y);
  f[4] = bf_lo(r.z); f[5] = bf_hi(r.z); f[6] = bf_lo(r.w); f[7] = bf_hi(r.w);
}
__device__ __forceinline__ void load8(const bf16* p, float* f) {
  uint4 r = *reinterpret_cast<const uint4*>(p);
  unpack8(r, f);
}
__device__ __forceinline__ void store4bf(bf16* p, float a, float b, float c, float d) {
  uint2 o; o.x = cvt_pk_bf16(a, b); o.y = cvt_pk_bf16(c, d);
  *reinterpret_cast<uint2*>(p) = o;
}
__device__ __forceinline__ float sigmoidf_(float x) { return 1.f / (1.f + __expf(-x)); }
__device__ __forceinline__ float tanhf_(float x) { const float t = __expf(-2.f * fabsf(x)); return copysignf((1.f - t) / (1.f + t), x); }
__device__ __forceinline__ float softplusf_(float z) { return fmaxf(z, 0.f) + __logf(1.f + __expf(-fabsf(z))); }

constexpr int BM = 256, BK = 64, HALF = 128, NXCD = 8, WGM = 8, HT = HALF * BK;
#define shm ((bf16*)smem_raw)

__device__ __forceinline__ int lds_byte(int r, int c) {
  int st = (r >> 4) * 2 + (c >> 5), rr = r & 15, cc = c & 31, ob = rr * 64 + cc * 2;
  return st * 1024 + (ob ^ (((ob >> 9) & 1) << 5));
}
__device__ __forceinline__ void stage_rc(int b, int& R, int& C) {
  int st = b / 1024, sb = b % 1024, swz = sb ^ (((sb >> 9) & 1) << 5);
  R = (st >> 1) * 16 + swz / 64; C = (st & 1) * 32 + (swz % 64) / 2;
}

#define SA(b, h) (shm + ((b) * 2 + (h)) * HT)
#define SB(b, h) (shm + (4 + (b) * 2 + (h)) * HT)
#define STAGE(P, BASE, br, kt) do { long _g = (long)(br) * K + (long)(kt) * BK; \
    for (int _i = 0; _i < 2; ++_i) { int _b = tid * 16 + _i * 8192; int _r, _c; stage_rc(_b, _r, _c); \
      __builtin_amdgcn_global_load_lds((const unsigned*)(BASE + _g + (long)_r * K + _c), \
        (unsigned*)((char*)(P) + _b), 16, 0, 0); } } while (0)
#define LDA(dst, b, h) for (int m = 0; m < 4; ++m) for (int k = 0; k < 2; ++k) \
    dst[m][k] = *reinterpret_cast<const bf16x8*>((char*)SA(b, h) + lds_byte(wr * 64 + m * 16 + fr, k * 32 + fq * 8))
#define LDB(dst, b, h) for (int n = 0; n < 2; ++n) for (int k = 0; k < 2; ++k) \
    dst[n][k] = *reinterpret_cast<const bf16x8*>((char*)SB(b, h) + lds_byte(wc * 32 + n * 16 + fr, k * 32 + fq * 8))
#define MMA(ai, bj, At, Bt_) do { __builtin_amdgcn_s_setprio(1); \
    for (int m = 0; m < 4; ++m) for (int n = 0; n < 2; ++n) for (int k = 0; k < 2; ++k) \
      acc[ai][bj][m][n] = __builtin_amdgcn_mfma_f32_16x16x32_bf16(Bt_[n][k], At[m][k], acc[ai][bj][m][n], 0, 0, 0); \
    __builtin_amdgcn_s_setprio(0); } while (0)
#define WAIT_V(n) asm volatile("s_waitcnt vmcnt(" #n ")" ::: "memory")
#define WAIT_L(n) asm volatile("s_waitcnt lgkmcnt(" #n ")" ::: "memory")
#define BAR __builtin_amdgcn_s_barrier()
#define SCHED __builtin_amdgcn_sched_barrier(0)

typedef f32x4 AccT[2][2][4][2];

__device__ __forceinline__ void gemm_one(const int tid_in, const bf16* __restrict__ A, const bf16* __restrict__ Bt, const int K_in,
                                         const int brow, const int bcol, AccT& acc) {
  int tid = tid_in; asm volatile("" : "+v"(tid));
  const int K = K_in;
  const int wid = tid >> 6, lane = tid & 63, wr = wid >> 2, wc = wid & 3, fr = lane & 15, fq = lane >> 4;
#pragma unroll
  for (int a = 0; a < 2; ++a)
#pragma unroll
    for (int b = 0; b < 2; ++b)
#pragma unroll
      for (int m = 0; m < 4; ++m)
#pragma unroll
        for (int n = 0; n < 2; ++n) acc[a][b][m][n] = f32x4{0.f, 0.f, 0.f, 0.f};
  bf16x8 At[4][2], B0[2][2], B1[2][2];
  const int nt = K / BK;
  STAGE(SB(0, 0), Bt, bcol, 0); STAGE(SA(0, 0), A, brow, 0);
  STAGE(SB(0, 1), Bt, bcol + HALF, 0); STAGE(SA(0, 1), A, brow + HALF, 0);
  if (wr == 1) BAR;
  WAIT_V(4); BAR;
  STAGE(SB(1, 0), Bt, bcol, 1); STAGE(SA(1, 0), A, brow, 1); STAGE(SB(1, 1), Bt, bcol + HALF, 1);
  WAIT_V(6); BAR;
#pragma unroll 1
  for (int t = 0; t < nt - 2; t += 2) {
    LDB(B0, 0, 0); SCHED; LDA(At, 0, 0); STAGE(SA(1, 1), A, brow + HALF, t + 1);
    WAIT_L(8); BAR; WAIT_L(0); MMA(0, 0, At, B0); BAR; SCHED;
    LDB(B1, 0, 1); STAGE(SB(0, 0), Bt, bcol, t + 2);
    BAR; WAIT_L(0); MMA(0, 1, At, B1); BAR;
    LDA(At, 0, 1); STAGE(SA(0, 0), A, brow, t + 2);
    BAR; WAIT_L(0); MMA(1, 0, At, B0); BAR; SCHED;
    STAGE(SB(0, 1), Bt, bcol + HALF, t + 2);
    WAIT_V(6); BAR; MMA(1, 1, At, B1); BAR;
    LDB(B0, 1, 0); SCHED; LDA(At, 1, 0); STAGE(SA(0, 1), A, brow + HALF, t + 2);
    WAIT_L(8); BAR; WAIT_L(0); MMA(0, 0, At, B0); BAR; SCHED;
    LDB(B1, 1, 1); STAGE(SB(1, 0), Bt, bcol, t + 3);
    BAR; WAIT_L(0); MMA(0, 1, At, B1); BAR;
    LDA(At, 1, 1); STAGE(SA(1, 0), A, brow, t + 3);
    BAR; WAIT_L(0); MMA(1, 0, At, B0); BAR; SCHED;
    STAGE(SB(1, 1), Bt, bcol + HALF, t + 3);
    WAIT_V(6); BAR; MMA(1, 1, At, B1); BAR;
  }
  { LDB(B0, 0, 0); LDA(At, 0, 0); STAGE(SA(1, 1), A, brow + HALF, nt - 1);
    BAR; WAIT_L(0); MMA(0, 0, At, B0); BAR;
    LDB(B1, 0, 1); BAR; WAIT_L(0); MMA(0, 1, At, B1); BAR;
    LDA(At, 0, 1); WAIT_V(4); BAR; WAIT_L(0); MMA(1, 0, At, B0); MMA(1, 1, At, B1); BAR; }
  { LDB(B0, 1, 0); LDA(At, 1, 0); WAIT_V(2); BAR; WAIT_L(0); MMA(0, 0, At, B0); BAR;
    LDB(B1, 1, 1); WAIT_V(0); BAR; WAIT_L(0); MMA(0, 1, At, B1); BAR;
    LDA(At, 1, 1); BAR; WAIT_L(0); MMA(1, 0, At, B0); MMA(1, 1, At, B1); BAR; }
  if (wr == 0) BAR;
}

__device__ __forceinline__ void tile_rc(int L, int nM, int nN, int& brow, int& bcol) {
  const int nwg = nM * nN;
  int wgid = L;
  { const int q = nwg / NXCD, r = nwg % NXCD, xcd = wgid % NXCD, off = wgid / NXCD;
    wgid = (xcd < r ? xcd * (q + 1) : r * (q + 1) + (xcd - r) * q) + off; }
  const int nig = WGM * nN, gid = wgid / nig, fm = gid * WGM, gsz = (nM - fm) < WGM ? (nM - fm) : WGM;
  const int pm = fm + ((wgid % nig) % gsz), pn = (wgid % nig) / gsz;
  brow = pm * BM; bcol = pn * BM;
}

#define EPI_VARS int tide_ = tid; asm volatile("" : "+v"(tide_)); const int wid_ = tide_ >> 6, lane_ = tide_ & 63, wr_ = wid_ >> 2, wc_ = wid_ & 3, fr_ = lane_ & 15, fq_ = lane_ >> 4;
#define EPI_LOOP _Pragma("unroll") for (int ai = 0; ai < 2; ++ai) _Pragma("unroll") for (int bj = 0; bj < 2; ++bj) \
    _Pragma("unroll") for (int m = 0; m < 4; ++m) _Pragma("unroll") for (int n = 0; n < 2; ++n)
#define EPI_ROW (brow + ai * 128 + wr_ * 64 + m * 16 + fr_)
#define EPI_COL (bcol + bj * 128 + wc_ * 32 + n * 16 + fq_ * 4)

__device__ __forceinline__ void ph_ffn_a(const bf16* H16, const bf16* Wgu, bf16* ACT) {
  PHASE_TID
  const int nM = MTOK / 256, nN = 5632 / 256;
  for (int L = bid; L < nM * nN; L += GRID) {
    int brow, bcol; tile_rc(L, nM, nN, brow, bcol);
    AccT acc; gemm_one(tid, H16, Wgu, DM, brow, bcol, acc);
    EPI_VARS
    const int u0 = (bcol >> 1);
#pragma unroll
    for (int ai = 0; ai < 2; ++ai)
#pragma unroll
      for (int m = 0; m < 4; ++m)
#pragma unroll
        for (int n = 0; n < 2; ++n) {
          const int row = brow + ai * 128 + wr_ * 64 + m * 16 + fr_;
          const int unit = u0 + wc_ * 32 + n * 16 + fq_ * 4;
          f32x4 g = acc[ai][0][m][n], u = acc[ai][1][m][n];
          float o[4];
#pragma unroll
          for (int j = 0; j < 4; ++j) o[j] = g[j] * sigmoidf_(g[j]) * u[j];
          store4bf(ACT + (size_t)row * DFF + unit, o[0], o[1], o[2], o[3]);
        }
  }
}
template <bool NORM>
__device__ __forceinline__ void ph_res(const bf16* A, const bf16* Bt, int K, float* H32, float scale, const float2* stats, const float* lg, const float* lb, const float* src = nullptr) {
  PHASE_TID
  const int nM = MTOK / 256, nN = DM / 256;
  for (int L = bid; L < nM * nN; L += GRID) {
    int brow, bcol; tile_rc(L, nM, nN, brow, bcol);
    AccT acc; gemm_one(tid, A, Bt, K, brow, bcol, acc);
    EPI_VARS
#pragma unroll
    for (int ai = 0; ai < 2; ++ai)
#pragma unroll
      for (int m = 0; m < 4; ++m) {
        const int row = brow + ai * 128 + wr_ * 64 + m * 16 + fr_;
        float2 st = make_float2(0.f, 1.f);
        if (NORM) st = stats[row];
#pragma unroll
        for (int bj = 0; bj < 2; ++bj)
#pragma unroll
          for (int n = 0; n < 2; ++n) {
            const int col = EPI_COL;
            float4* p = reinterpret_cast<float4*>(H32 + (size_t)row * DM + col);
            float4 v = NORM ? *p : *reinterpret_cast<const float4*>(src + (size_t)row * DM + col);
            f32x4 a = acc[ai][bj][m][n];
            if (NORM) {
              const float4 g4 = *reinterpret_cast<const float4*>(lg + col), b4 = *reinterpret_cast<const float4*>(lb + col);
              v.x = (v.x - st.x) * st.y * g4.x + b4.x; v.y = (v.y - st.x) * st.y * g4.y + b4.y;
              v.z = (v.z - st.x) * st.y * g4.z + b4.z; v.w = (v.w - st.x) * st.y * g4.w + b4.w;
            }
            v.x = ALPHA_F * v.x + scale * a[0]; v.y = ALPHA_F * v.y + scale * a[1];
            v.z = ALPHA_F * v.z + scale * a[2]; v.w = ALPHA_F * v.w + scale * a[3];
            *p = v;
            __builtin_amdgcn_sched_barrier(0);
          }
      }
  }
}
template <bool SIG>
__device__ __forceinline__ void ph_proj(const bf16* A, const bf16* Bt, int N, int K, bf16* C, int ldc) {
  PHASE_TID
  const int nM = MTOK / 256, nN = N / 256;
  for (int L = bid; L < nM * nN; L += GRID) {
    int brow, bcol; tile_rc(L, nM, nN, brow, bcol);
    AccT acc; gemm_one(tid, A, Bt, K, brow, bcol, acc);
    EPI_VARS
    EPI_LOOP {
      f32x4 a = acc[ai][bj][m][n];
      if (SIG) { a[0] = sigmoidf_(a[0]); a[1] = sigmoidf_(a[1]); a[2] = sigmoidf_(a[2]); a[3] = sigmoidf_(a[3]); }
      store4bf(C + (size_t)EPI_ROW * ldc + EPI_COL, a[0], a[1], a[2], a[3]);
    }
  }
}
__device__ __forceinline__ void ph_merge(const bf16* Y0, const bf16* Y1, const bf16* Y2, const bf16* Wbr, const bf16* GATE, float* M32, bf16* OUT16) {
  PHASE_TID
  const int nM = MTOK / 256, nN = DM / 256;
  for (int L = bid; L < nM * nN; L += GRID) {
    int brow, bcol; tile_rc(L, nM, nN, brow, bcol);
#pragma unroll 1
    for (int br = 0; br < 3; ++br) {
      const bf16* Y = br == 0 ? Y0 : (br == 1 ? Y1 : Y2);
      AccT acc; gemm_one(tid, Y, Wbr + (size_t)br * 1024 * 512, 512, brow, bcol, acc);
      EPI_VARS
      EPI_LOOP {
        const size_t row = EPI_ROW; const int col = EPI_COL;
        uint2 gr = *reinterpret_cast<const uint2*>(GATE + row * 3072 + br * 1024 + col);
        f32x4 a = acc[ai][bj][m][n];
        float z0 = bf_lo(gr.x) * a[0], z1 = bf_hi(gr.x) * a[1], z2 = bf_lo(gr.y) * a[2], z3 = bf_hi(gr.y) * a[3];
        bf16* p = reinterpret_cast<bf16*>(M32) + row * DM + col;
        if (br == 0) { store4bf(p, z0, z1, z2, z3); }
        else {
          const uint2 pr = *reinterpret_cast<const uint2*>(p);
          const float v0 = bf_lo(pr.x) + z0, v1 = bf_hi(pr.x) + z1, v2 = bf_lo(pr.y) + z2, v3 = bf_hi(pr.y) + z3;
          if (br == 1) store4bf(p, v0, v1, v2, v3); else store4bf(OUT16 + row * DM + col, v0, v1, v2, v3);
        }
        __builtin_amdgcn_sched_barrier(0);
      }
    }
  }
}
__device__ __forceinline__ void ph_ple(const bf16* H16, const bf16* P16, const bf16* Wpg, const bf16* Wpp, float* T32, float* H32, const float2* stats, const float* lg, const float* lb) {
  PHASE_TID
  const int nM = MTOK / 256, nN = DM / 256;
  for (int L = bid; L < nM * nN; L += GRID) {
    int brow, bcol; tile_rc(L, nM, nN, brow, bcol);
    {
      AccT acc; gemm_one(tid, P16, Wpp, 256, brow, bcol, acc);
      EPI_VARS
      EPI_LOOP {
        f32x4 a = acc[ai][bj][m][n];
        store4bf(reinterpret_cast<bf16*>(T32) + (size_t)EPI_ROW * DM + EPI_COL, a[0], a[1], a[2], a[3]);
        __builtin_amdgcn_sched_barrier(0);
      }
    }
    {
      AccT acc; gemm_one(tid, H16, Wpg, DM, brow, bcol, acc);
      EPI_VARS
      EPI_LOOP {
        const int row_ = EPI_ROW, col_ = EPI_COL;
        const size_t o = (size_t)row_ * DM + col_;
        const uint2 tr_ = *reinterpret_cast<const uint2*>(reinterpret_cast<const bf16*>(T32) + o);
        const float4 t = make_float4(bf_lo(tr_.x), bf_hi(tr_.x), bf_lo(tr_.y), bf_hi(tr_.y));
        float4* p = reinterpret_cast<float4*>(H32 + o);
        float4 v = *p; f32x4 a = acc[ai][bj][m][n];
        {
          const float2 st = stats[row_];
          const float4 g4 = *reinterpret_cast<const float4*>(lg + col_), b4 = *reinterpret_cast<const float4*>(lb + col_);
          v.x = (v.x - st.x) * st.y * g4.x + b4.x; v.y = (v.y - st.x) * st.y * g4.y + b4.y;
          v.z = (v.z - st.x) * st.y * g4.z + b4.z; v.w = (v.w - st.x) * st.y * g4.w + b4.w;
        }
        v.x = ALPHA_F * v.x + sigmoidf_(a[0]) * t.x; v.y = ALPHA_F * v.y + sigmoidf_(a[1]) * t.y;
        v.z = ALPHA_F * v.z + sigmoidf_(a[2]) * t.z; v.w = ALPHA_F * v.w + sigmoidf_(a[3]) * t.w;
        *p = v;
        __builtin_amdgcn_sched_barrier(0);
      }
    }
  }
}

__device__ __forceinline__ float wave_sum(float v) {
#pragma unroll
  for (int o = 1; o < 64; o <<= 1) v += __shfl_xor(v, o);
  return v;
}
__device__ __forceinline__ void ph_ln(float* H32, bf16* H16, const float* g, const float* b, float* outp, float2* stats) {
  PHASE_TID
  const int lane = tid & 63, wave = tid >> 6;
  float4 gg[4], bb[4];
#pragma unroll
  for (int j = 0; j < 4; ++j) { gg[j] = reinterpret_cast<const float4*>(g)[lane + 64 * j]; bb[j] = reinterpret_cast<const float4*>(b)[lane + 64 * j]; }
  for (int row = bid * 8 + wave; row < MTOK; row += GRID * 8) {
    float4* xr = reinterpret_cast<float4*>(H32 + (size_t)row * DM);
    float4 v[4]; float s = 0.f;
#pragma unroll
    for (int j = 0; j < 4; ++j) { v[j] = xr[lane + 64 * j]; s += (v[j].x + v[j].y) + (v[j].z + v[j].w); }
    const float mean = wave_sum(s) * (1.f / DM);
    float s2 = 0.f;
#pragma unroll
    for (int j = 0; j < 4; ++j) {
      v[j].x -= mean; v[j].y -= mean; v[j].z -= mean; v[j].w -= mean;
      s2 += (v[j].x * v[j].x + v[j].y * v[j].y) + (v[j].z * v[j].z + v[j].w * v[j].w);
    }
    const float rstd = rsqrtf(wave_sum(s2) * (1.f / DM) + 1e-5f);
#pragma unroll
    for (int j = 0; j < 4; ++j) {
      float4 y;
      y.x = v[j].x * rstd * gg[j].x + bb[j].x; y.y = v[j].y * rstd * gg[j].y + bb[j].y;
      y.z = v[j].z * rstd * gg[j].z + bb[j].z; y.w = v[j].w * rstd * gg[j].w + bb[j].w;
      if (outp) { reinterpret_cast<float4*>(outp + (size_t)row * DM)[lane + 64 * j] = y; }
      else {
        store4bf(H16 + (size_t)row * DM + (lane + 64 * j) * 4, y.x, y.y, y.z, y.w);
      }
    }
    if (!outp && lane == 0) stats[row] = make_float2(mean, rstd);
  }
}

__device__ __forceinline__ void ph_pconv(KP P, int layer) {
  PHASE_TID
  const size_t gt = (size_t)bid * 512 + tid, gn = (size_t)GRID * 512;
  const float4* src = reinterpret_cast<const float4*>(P->in[1] + (size_t)layer * MTOK * 256);
  bf16* dst = reinterpret_cast<bf16*>(P->ws + OFF_P16);
  for (size_t i = gt; i < (size_t)MTOK * 256 / 4; i += gn) { float4 v = src[i]; store4bf(dst + i * 4, v.x, v.y, v.z, v.w); }
}
__device__ __forceinline__ void conv_mat(const int tid, const int bid, const float* W, int ldw, int col0, int ncols, int K, bf16* WT, int mode, const int nblocks = GRID) {
  const int lane = tid & 63, wave = tid >> 6;
  float* scr = reinterpret_cast<float*>(smem_raw) + wave * (64 * 33);
  const int nblk = ncols / 32, nitems = (K / 64) * nblk;
  for (int item = bid * 8 + wave; item < nitems; item += nblocks * 8) {
    const int kb = item / nblk, nb = item % nblk, k0 = 64 * kb, n0 = 32 * nb;
    {
      float v[32];
      const float* src = W + (size_t)(k0 + (lane >> 5)) * ldw + col0 + n0 + (lane & 31);
#pragma unroll
      for (int i = 0; i < 32; ++i) v[i] = src[(size_t)(2 * i) * ldw];
#pragma unroll
      for (int i = 0; i < 32; ++i) scr[(2 * i + (lane >> 5)) * 33 + (lane & 31)] = v[i];
    }
    __builtin_amdgcn_wave_barrier(); asm volatile("s_waitcnt lgkmcnt(0)" ::: "memory");
    const int c = lane & 7;
#pragma unroll
    for (int j = 0; j < 4; ++j) {
      const int n = (lane >> 3) + 8 * j; const float* s = scr + (8 * c) * 33 + n;
      uint4 o; o.x = cvt_pk_bf16(s[0 * 33], s[1 * 33]); o.y = cvt_pk_bf16(s[2 * 33], s[3 * 33]);
      o.z = cvt_pk_bf16(s[4 * 33], s[5 * 33]); o.w = cvt_pk_bf16(s[6 * 33], s[7 * 33]);
      const int nn = n0 + n;
      const int drow = mode == 0 ? nn : ((nn >> 7) * 256 + (nn & 127) + (mode == 2 ? 128 : 0));
      *reinterpret_cast<uint4*>(WT + (size_t)drow * K + k0 + 8 * c) = o;
    }
    __builtin_amdgcn_wave_barrier(); asm volatile("s_waitcnt lgkmcnt(0)" ::: "memory");
  }
}
__device__ __forceinline__ void ph_convert(KP P, int layer, bool first) {
  PHASE_TID
  bf16* W = reinterpret_cast<bf16*>(P->ws + OFF_W);
  const size_t l = layer;
  if (first) {
    conv_mat(tid, bid, P->in[4] + l * DM * DFF, DFF, 0, DFF, DM, W + W_F1GU, 1);
    conv_mat(tid, bid, P->in[5] + l * DM * DFF, DFF, 0, DFF, DM, W + W_F1GU, 2);
    conv_mat(tid, bid, P->in[6] + l * DFF * DM, DM, 0, DM, DFF, W + W_F1D, 0);
  }
  const float* win = P->in[7] + l * DM * 8480;
  conv_mat(tid, bid, win, 8480, 0, 1824, DM, W + W_RW, 0);
  conv_mat(tid, bid, win, 8480, 1824, 1536, DM, W + W_SB, 0);
  conv_mat(tid, bid, win, 8480, 3360, 2048, DM, W + W_HG, 0);
  conv_mat(tid, bid, win, 8480, 5408, 3072, DM, W + W_GATE, 0);
  conv_mat(tid, bid, P->in[21] + l * 512 * DM, DM, 0, DM, 512, W + W_BR, 0);
  conv_mat(tid, bid, P->in[22] + l * 512 * DM, DM, 0, DM, 512, W + W_BR + 1024 * 512, 0);
  conv_mat(tid, bid, P->in[23] + l * 512 * DM, DM, 0, DM, 512, W + W_BR + 2 * 1024 * 512, 0);
  conv_mat(tid, bid, P->in[24] + l * DM * DM, DM, 0, DM, DM, W + W_OUT, 0);
  conv_mat(tid, bid, P->in[28] + l * DM * DM, DM, 0, DM, DM, W + W_PG, 0);
  conv_mat(tid, bid, P->in[29] + l * 256 * DM, DM, 0, DM, 256, W + W_PP, 0);
  const size_t gt = (size_t)bid * 512 + tid, gn = (size_t)GRID * 512;
  { uint4 z = make_uint4(0, 0, 0, 0); uint4* d = reinterpret_cast<uint4*>(W + W_RW + (size_t)1824 * DM);
    for (size_t i = gt; i < (size_t)224 * DM / 8; i += gn) d[i] = z; }
  if (first) {
    const float4* src = reinterpret_cast<const float4*>(P->in[0]);
    bf16* h16 = reinterpret_cast<bf16*>(P->ws + OFF_H16);
    for (size_t i = gt; i < (size_t)MTOK * DM / 4; i += gn) { float4 v = src[i]; store4bf(h16 + i * 4, v.x, v.y, v.z, v.w); }
  }
}

#define MMK(KK, AEXPR, BEXPR) _Pragma("unroll 2") for (int k0_ = 0; k0_ < (KK); k0_ += 16) { _Pragma("unroll") for (int st_ = 0; st_ < 4; ++st_) { const int k = k0_ + 4 * kq + st_; \
    _Pragma("unroll") for (int u_ = 0; u_ < 2; ++u_) { const int i = ii[u_], j = jj[u_]; \
      acc[u_] = __builtin_amdgcn_mfma_f32_16x16x4f32((AEXPR), (BEXPR), acc[u_], 0, 0, 0); } } }
#define MMKG(KK, AEXPR, BEXPR) _Pragma("unroll 2") for (int k0_ = 0; k0_ < (KK); k0_ += 16) { _Pragma("unroll") for (int st_ = 0; st_ < 4; ++st_) { const int k = k0_ + 4 * kq + st_; \
    _Pragma("unroll") for (int u_ = 0; u_ < 2; ++u_) { const int i = ii[u_], j = jj[u_]; \
      acc[u_] = __builtin_amdgcn_mfma_f32_16x16x4f32((AEXPR), (BEXPR), acc[u_], 0, 0, 0); } } }
template <int TM, int TN, class FK, class FC>
__device__ __forceinline__ void mm16(const int tid, FK fk, FC fc) {
  const int wave = tid >> 6, lane = tid & 63, li = lane & 15, kq = lane >> 4;
#pragma unroll 1
  for (int t = wave; t < TM * TN; t += 16) {
    const int t1 = t + 8;
    const int ti0 = t / TN, tj0 = t % TN, ti1 = t1 / TN, tj1 = t1 % TN;
    f32x4 acc[2] = {f32x4{0.f, 0.f, 0.f, 0.f}, f32x4{0.f, 0.f, 0.f, 0.f}};
    const int ii[2] = {ti0 * 16 + li, ti1 * 16 + li}, jj[2] = {tj0 * 16 + li, tj1 * 16 + li};
    fk(acc, ii, jj, kq);
#pragma unroll
    for (int r = 0; r < 4; ++r) fc(ti0 * 16 + kq * 4 + r, tj0 * 16 + li, acc[0][r]);
#pragma unroll
    for (int r = 0; r < 4; ++r) fc(ti1 * 16 + kq * 4 + r, tj1 * 16 + li, acc[1][r]);
  }
}

template <int TM, int TN, int K, class FC>
__device__ __forceinline__ void mmb(const int tid, const bf16* A, const int lda, const bf16* B, const int ldb, FC fc) {
  const int wave = tid >> 6, lane = tid & 63, li = lane & 15, kq = lane >> 4;
#pragma unroll 1
  for (int t = wave; t < TM * TN; t += 16) {
    const int t1 = t + 8;
    const int ti0 = t / TN, tj0 = t % TN, ti1 = t1 / TN, tj1 = t1 % TN;
    f32x4 acc0 = {0.f, 0.f, 0.f, 0.f}, acc1 = {0.f, 0.f, 0.f, 0.f};
    const bf16* a0 = A + (ti0 * 16 + li) * lda + kq * 8;
    const bf16* a1 = A + (ti1 * 16 + li) * lda + kq * 8;
    const bf16* b0 = B + (tj0 * 16 + li) * ldb + kq * 8;
    const bf16* b1 = B + (tj1 * 16 + li) * ldb + kq * 8;
#pragma unroll
    for (int kk = 0; kk < K; kk += 32) {
      acc0 = __builtin_amdgcn_mfma_f32_16x16x32_bf16(*reinterpret_cast<const bf16x8*>(a0 + kk), *reinterpret_cast<const bf16x8*>(b0 + kk), acc0, 0, 0, 0);
      acc1 = __builtin_amdgcn_mfma_f32_16x16x32_bf16(*reinterpret_cast<const bf16x8*>(a1 + kk), *reinterpret_cast<const bf16x8*>(b1 + kk), acc1, 0, 0, 0);
    }
#pragma unroll
    for (int r = 0; r < 4; ++r) fc(ti0 * 16 + kq * 4 + r, tj0 * 16 + li, acc0[r]);
#pragma unroll
    for (int r = 0; r < 4; ++r) fc(ti1 * 16 + kq * 4 + r, tj1 * 16 + li, acc1[r]);
  }
}
__device__ __forceinline__ void scatter8(const uint4 r, unsigned short* dst, int ld) {
  dst[0 * ld] = (unsigned short)(r.x & 0xffff); dst[1 * ld] = (unsigned short)(r.x >> 16);
  dst[2 * ld] = (unsigned short)(r.y & 0xffff); dst[3 * ld] = (unsigned short)(r.y >> 16);
  dst[4 * ld] = (unsigned short)(r.z & 0xffff); dst[5 * ld] = (unsigned short)(r.z >> 16);
  dst[6 * ld] = (unsigned short)(r.w & 0xffff); dst[7 * ld] = (unsigned short)(r.w >> 16);
}

__device__ __forceinline__ void ph_sb(const bf16* U, bf16* YSB) {
  bf16* Qb = reinterpret_cast<bf16*>(smem_raw);
  bf16* Kb = Qb + 64 * 136;
  bf16* Vt = Kb + 64 * 136;
  bf16* Ab = Vt + 128 * 72;
  float* Zs = reinterpret_cast<float*>(Ab + 64 * 72);
  PHASE_TID
  const int wave = tid >> 6, lane = tid & 63, li = lane & 15, kq = lane >> 4;
  for (int task = bid; task < 2048; task += GRID) {
    const int qt = task & 127, h = (task >> 7) & 3, b = task >> 9;
    const size_t tok0 = (size_t)b * SEQ + qt * 64;
    const int e0 = tid, e1 = tid + 512;
    const bf16* kbase = U + (size_t)b * SEQ * LDU + 512 + h * 128;
    const bf16* vbase = U + (size_t)b * SEQ * LDU + 1024 + h * 128;
    const size_t ko0 = (size_t)(e0 >> 4) * LDU + (e0 & 15) * 8, ko1 = (size_t)(e1 >> 4) * LDU + (e1 & 15) * 8;
    const size_t vo0 = (size_t)(e0 & 63) * LDU + (e0 >> 6) * 8, vo1 = (size_t)(e1 & 63) * LDU + (e1 >> 6) * 8;
    uint4 kr0, kr1, vr0, vr1;
    {
      const size_t kt0 = (size_t)qt * 64 * LDU;
      kr0 = *reinterpret_cast<const uint4*>(kbase + kt0 + ko0); kr1 = *reinterpret_cast<const uint4*>(kbase + kt0 + ko1);
      vr0 = *reinterpret_cast<const uint4*>(vbase + kt0 + vo0); vr1 = *reinterpret_cast<const uint4*>(vbase + kt0 + vo1);
    }
    __syncthreads();
#pragma unroll
    for (int i = 0; i < 2; ++i) {
      const int e = tid + 512 * i, r = e >> 4, c8 = (e & 15) * 8;
      *reinterpret_cast<uint4*>(Qb + r * 136 + c8) = *reinterpret_cast<const uint4*>(U + (tok0 + r) * LDU + h * 128 + c8);
    }
    f32x4 o[4];
#pragma unroll
    for (int c = 0; c < 4; ++c) o[c] = f32x4{0.f, 0.f, 0.f, 0.f};
    float carry = 0.f;
    const int row = tid >> 3, part = tid & 7;
    const int rt = wave & 3, cb = (wave >> 2) * 64;
    for (int kt = qt; kt >= 0; --kt) {
      __syncthreads();
      *reinterpret_cast<uint4*>(Kb + (e0 >> 4) * 136 + (e0 & 15) * 8) = kr0;
      *reinterpret_cast<uint4*>(Kb + (e1 >> 4) * 136 + (e1 & 15) * 8) = kr1;
      scatter8(vr0, reinterpret_cast<unsigned short*>(Vt) + ((e0 >> 6) * 8) * 72 + (e0 & 63), 72);
      scatter8(vr1, reinterpret_cast<unsigned short*>(Vt) + ((e1 >> 6) * 8) * 72 + (e1 & 63), 72);
      if (kt > 0) {
        const size_t kt0 = (size_t)(kt - 1) * 64 * LDU;
        kr0 = *reinterpret_cast<const uint4*>(kbase + kt0 + ko0); kr1 = *reinterpret_cast<const uint4*>(kbase + kt0 + ko1);
        vr0 = *reinterpret_cast<const uint4*>(vbase + kt0 + vo0); vr1 = *reinterpret_cast<const uint4*>(vbase + kt0 + vo1);
      }
      __syncthreads();
      mmb<4, 4, 128>(tid, Qb, 136, Kb, 136, [&](int r, int c, float v) { Zs[r * 68 + c] = v * 0.08838834764831845f; });
      __syncthreads();
      {
        const float* zp = Zs + row * 68 + part * 8;
        const int qg = qt * 64 + row, kg0 = kt * 64 + part * 8;
        float z[8], w[8];
#pragma unroll
        for (int j = 0; j < 8; ++j) z[j] = zp[j];
        float run = 0.f;
#pragma unroll
        for (int j = 7; j >= 0; --j) { const bool valid = (kg0 + j) < qg; run += valid ? -softplusf_(z[j]) : 0.f; w[j] = run; }
        const float tot = run;
        float incl = tot;
#pragma unroll
        for (int d = 1; d < 8; d <<= 1) { const float o_ = __shfl_down(incl, d, 8); if (part + d < 8) incl += o_; }
        const float excl = incl - tot;
        float a[8];
#pragma unroll
        for (int j = 0; j < 8; ++j) { const bool valid = (kg0 + j) < qg; a[j] = valid ? __expf(z[j] + w[j] + excl + carry) : 0.f; }
        uint4 pk; pk.x = cvt_pk_bf16(a[0], a[1]); pk.y = cvt_pk_bf16(a[2], a[3]); pk.z = cvt_pk_bf16(a[4], a[5]); pk.w = cvt_pk_bf16(a[6], a[7]);
        *reinterpret_cast<uint4*>(Ab + row * 72 + part * 8) = pk;
        carry += __shfl(incl, 0, 8);
      }
      __syncthreads();
      {
        const bf16* ap = Ab + (rt * 16 + li) * 72 + kq * 8;
#pragma unroll
        for (int kk = 0; kk < 64; kk += 32) {
          const bf16x8 a = *reinterpret_cast<const bf16x8*>(ap + kk);
#pragma unroll
          for (int c = 0; c < 4; ++c)
            o[c] = __builtin_amdgcn_mfma_f32_16x16x32_bf16(a, *reinterpret_cast<const bf16x8*>(Vt + (cb + c * 16 + li) * 72 + kq * 8 + kk), o[c], 0, 0, 0);
        }
      }
      if (__syncthreads_and(carry < -90.f)) break;
    }
#pragma unroll
    for (int c = 0; c < 4; ++c)
#pragma unroll
      for (int r = 0; r < 4; ++r) {
        const int ri = rt * 16 + kq * 4 + r, col = cb + c * 16 + li;
        YSB[(tok0 + ri) * 512 + h * 128 + col] = __float2bfloat16(o[c][r]);
      }
  }
}

#define RB(i) (sm + (i) * 4352)
__device__ __forceinline__ void lerp8(const bf16* U, size_t tok, bool hasprev, int col, const float* mu, float* out) {
  float c[8], p[8];
  load8(U + tok * LDU + col, c);
  if (hasprev) load8(U + (tok - 1) * LDU + col, p);
  else {
#pragma unroll
    for (int j = 0; j < 8; ++j) p[j] = 0.f;
  }
  const float4 m0 = *reinterpret_cast<const float4*>(mu + col), m1 = *reinterpret_cast<const float4*>(mu + col + 4);
  const float mm[8] = {m0.x, m0.y, m0.z, m0.w, m1.x, m1.y, m1.z, m1.w};
#pragma unroll
  for (int j = 0; j < 8; ++j) out[j] = c[j] + (p[j] - c[j]) * mm[j];
}
__device__ __forceinline__ void store_bf16_at(bf16* p, float v) { *p = __float2bfloat16(v); }

__device__ __forceinline__ void ph_rwkv_a(KP P, int layer) {
  float* sm = reinterpret_cast<float*>(smem_raw);
  float* GL = sm + 8 * 4352;
  const bf16* U = reinterpret_cast<const bf16*>(P->ws + OFF_U);
  float* Pg = reinterpret_cast<float*>(P->ws + OFF_RP);
  float* Dg = reinterpret_cast<float*>(P->ws + OFF_RD);
  bf16* YIg = reinterpret_cast<bf16*>(P->ws + OFF_RYI);
  bf16* QEg = reinterpret_cast<bf16*>(P->ws + OFF_RQE);
  bf16* GTg = reinterpret_cast<bf16*>(P->ws + OFF_RGT);
  float* BCg = reinterpret_cast<float*>(P->ws + OFF_RBC);
  const float* mu = P->in[8] + (size_t)layer * 1824;
  const float* w0 = P->in[9] + (size_t)layer * 512;
  const float* wup = P->in[10] + (size_t)layer * 64 * 512;
  const float* a0 = P->in[11] + (size_t)layer * 512;
  const float* aup = P->in[12] + (size_t)layer * 64 * 512;
  const float* gup = P->in[13] + (size_t)layer * 160 * 512;
  const float* k_k = P->in[14] + (size_t)layer * 512;
  const float* k_a = P->in[15] + (size_t)layer * 512;
  const float* r_k = P->in[16] + (size_t)layer * 512;
  PHASE_TID
  const int et = tid >> 3, en = (tid & 7) * 8;
  for (int task = bid; task < 4096; task += GRID) {
    const int c = task & 127, h = (task >> 7) & 7, b = task >> 10;
    const size_t tok0 = (size_t)b * SEQ + c * 64;
    const size_t tok = tok0 + et;
    const bool hasprev = (c * 64 + et) > 0;
    const int hc = h * 64;
    float r[8], k[8], v[8], xw[8], xa[8];
    lerp8(U, tok, hasprev, 1536 + en, mu, xw);
    lerp8(U, tok, hasprev, 1600 + en, mu, xa);
    lerp8(U, tok, hasprev, hc + en, mu, r);
    lerp8(U, tok, hasprev, 512 + hc + en, mu, k);
    lerp8(U, tok, hasprev, 1024 + hc + en, mu, v);
    const int wk0 = tid >> 4, wc4 = (tid & 15) * 4;
    const float4 wu0 = *reinterpret_cast<const float4*>(wup + (size_t)wk0 * 512 + hc + wc4);
    const float4 wu1 = *reinterpret_cast<const float4*>(wup + (size_t)(wk0 + 32) * 512 + hc + wc4);
    const float4 au0 = *reinterpret_cast<const float4*>(aup + (size_t)wk0 * 512 + hc + wc4);
    const float4 au1 = *reinterpret_cast<const float4*>(aup + (size_t)(wk0 + 32) * 512 + hc + wc4);
    __syncthreads();
    bf16* XWb = reinterpret_cast<bf16*>(RB(0)); bf16* XAb = reinterpret_cast<bf16*>(RB(1));
    bf16* WUt = reinterpret_cast<bf16*>(RB(4)); bf16* AUt = reinterpret_cast<bf16*>(RB(5));
    {
      uint4 pw, pa;
      pw.x = cvt_pk_bf16(tanhf_(xw[0]), tanhf_(xw[1])); pw.y = cvt_pk_bf16(tanhf_(xw[2]), tanhf_(xw[3]));
      pw.z = cvt_pk_bf16(tanhf_(xw[4]), tanhf_(xw[5])); pw.w = cvt_pk_bf16(tanhf_(xw[6]), tanhf_(xw[7]));
      pa.x = cvt_pk_bf16(xa[0], xa[1]); pa.y = cvt_pk_bf16(xa[2], xa[3]); pa.z = cvt_pk_bf16(xa[4], xa[5]); pa.w = cvt_pk_bf16(xa[6], xa[7]);
      *reinterpret_cast<uint4*>(XWb + et * 72 + en) = pw;
      *reinterpret_cast<uint4*>(XAb + et * 72 + en) = pa;
#define T4(DST, LD, V, OFF) do { (DST)[0 * (LD) + (OFF)] = __float2bfloat16((V).x); (DST)[1 * (LD) + (OFF)] = __float2bfloat16((V).y); \
    (DST)[2 * (LD) + (OFF)] = __float2bfloat16((V).z); (DST)[3 * (LD) + (OFF)] = __float2bfloat16((V).w); } while (0)
      T4(WUt + wc4 * 72 + wk0, 72, wu0, 0); T4(WUt + wc4 * 72 + wk0, 72, wu1, 32);
      T4(AUt + wc4 * 72 + wk0, 72, au0, 0); T4(AUt + wc4 * 72 + wk0, 72, au1, 32);
    }
    __syncthreads();
    mmb<4, 4, 64>(tid, XWb, 72, WUt, 72,
                  [&](int rr, int cc, float val) { const float wp = w0[hc + cc] + val; RB(2)[rr * 68 + cc] = -__expf(-softplusf_(-wp) - 0.5f); });
    mmb<4, 4, 64>(tid, XAb, 72, AUt, 72,
                  [&](int rr, int cc, float val) { RB(3)[rr * 68 + cc] = sigmoidf_(a0[hc + cc] + val); });
    __syncthreads();
    mm16<4, 4>(tid, [&](f32x4* acc, const int* ii, const int* jj, int kq) { MMK(64, (k <= i ? 1.f : 0.f), RB(2)[k * 68 + j]) },
               [&](int rr, int cc, float val) { RB(0)[rr * 68 + cc] = val; if (rr == 63) GL[cc] = __expf(val); });
    __syncthreads();
    {
      float kk[8], ss = 0.f;
#pragma unroll
      for (int j = 0; j < 8; ++j) { kk[j] = k[j] * k_k[hc + en + j]; ss += kk[j] * kk[j]; }
      ss += __shfl_xor(ss, 1); ss += __shfl_xor(ss, 2); ss += __shfl_xor(ss, 4);
      const float inv = 1.f / fmaxf(sqrtf(ss), 1e-12f);
      float bc = 0.f;
#pragma unroll
      for (int j = 0; j < 8; ++j) {
        const int n = en + j, o = et * 68 + n;
        const float as = RB(3)[o], lw = RB(2)[o], g = RB(0)[o];
        const float kkn = kk[j] * inv;
        const float kp = k[j] * (1.f + (as - 1.f) * k_a[hc + n]);
        const float einv = __expf(-g);
        RB(4)[o] = -kkn * __expf(g - lw);
        RB(5)[o] = r[j] * __expf(g);
        RB(6)[o] = kkn * as * einv;
        RB(7)[o] = kp * einv;
        RB(1)[o] = v[j];
        bc += r[j] * kp * r_k[hc + n];
      }
      bc += __shfl_xor(bc, 1); bc += __shfl_xor(bc, 2); bc += __shfl_xor(bc, 4);
      if ((tid & 7) == 0) BCg[(size_t)task * 64 + et] = bc;
    }
    __syncthreads();
    mm16<4, 4>(tid, [&](f32x4* acc, const int* ii, const int* jj, int kq) { MMK(64, RB(4)[i * 68 + k], RB(6)[j * 68 + k]) },
               [&](int rr, int cc, float val) { RB(2)[rr * 68 + cc] = cc < rr ? val : 0.f; });
    mm16<4, 4>(tid, [&](f32x4* acc, const int* ii, const int* jj, int kq) { MMK(64, RB(4)[i * 68 + k], RB(7)[j * 68 + k]) },
               [&](int rr, int cc, float val) { RB(3)[rr * 68 + cc] = cc < rr ? val : 0.f; });
    __syncthreads();
    mm16<4, 4>(tid, [&](f32x4* acc, const int* ii, const int* jj, int kq) { MMK(64, RB(3)[i * 68 + k], RB(1)[k * 68 + j]) },
               [&](int rr, int cc, float val) { RB(0)[rr * 68 + cc] = val; });
    __syncthreads();
    mm16<4, 4>(tid, [&](f32x4* acc, const int* ii, const int* jj, int kq) { MMK(64, RB(5)[i * 68 + k], RB(6)[j * 68 + k]) },
               [&](int rr, int cc, float val) { RB(3)[rr * 68 + cc] = cc <= rr ? val : 0.f; });
    float* TI = GL + 64;
    if (tid < 64) {
      const int d = tid >> 4, cdx = tid & 15;
      const float* Ld = RB(2) + (d * 16) * 68 + d * 16;
      float x[16];
#pragma unroll
      for (int r = 0; r < 16; ++r) {
        float a = (r == cdx) ? 1.f : 0.f;
#pragma unroll
        for (int s2 = 0; s2 < r; ++s2) a = fmaf(Ld[r * 68 + s2], x[s2], a);
        x[r] = a;
        TI[(d * 16 + r) * 16 + cdx] = a;
      }
    }
    __syncthreads();
    {
      const int wv = tid >> 6, ln = tid & 63, li = ln & 15, kq = ln >> 4;
      float* slab = (wv < 4 ? RB(4) : RB(0)) + (wv & 3) * 16;
      const float* Lm = RB(2);
#pragma unroll
      for (int i = 0; i < 4; ++i) {
        f32x4 acc;
#pragma unroll
        for (int r = 0; r < 4; ++r) acc[r] = slab[(16 * i + 4 * kq + r) * 68 + li];
#pragma unroll
        for (int kb = 0; kb < i; ++kb)
#pragma unroll
          for (int st = 0; st < 4; ++st) {
            const int k = kb * 16 + 4 * kq + st;
            acc = __builtin_amdgcn_mfma_f32_16x16x4f32(Lm[(16 * i + li) * 68 + k], slab[k * 68 + li], acc, 0, 0, 0);
          }
#pragma unroll
        for (int r = 0; r < 4; ++r) slab[(16 * i + 4 * kq + r) * 68 + li] = acc[r];
        asm volatile("s_waitcnt lgkmcnt(0)" ::: "memory");
        __builtin_amdgcn_wave_barrier();
        f32x4 xo = {0.f, 0.f, 0.f, 0.f};
#pragma unroll
        for (int st = 0; st < 4; ++st) {
          const int k = 4 * kq + st;
          xo = __builtin_amdgcn_mfma_f32_16x16x4f32(TI[(i * 16 + li) * 16 + k], slab[(16 * i + k) * 68 + li], xo, 0, 0, 0);
        }
        asm volatile("s_waitcnt lgkmcnt(0)" ::: "memory");
        __builtin_amdgcn_wave_barrier();
#pragma unroll
        for (int r = 0; r < 4; ++r) slab[(16 * i + 4 * kq + r) * 68 + li] = xo[r];
        asm volatile("s_waitcnt lgkmcnt(0)" ::: "memory");
        __builtin_amdgcn_wave_barrier();
      }
    }
    __syncthreads();
    {
      float* Pt = Pg + (size_t)task * 4096;
      float* Dt = Dg + (size_t)task * 4096;
      bf16* Qt = QEg + (size_t)task * 4096;
      mm16<4, 4>(tid, [&](f32x4* acc, const int* ii, const int* jj, int kq) { MMK(64, RB(4)[k * 68 + i], RB(6)[k * 68 + j]) },
                 [&](int rr, int cc, float val) { Pt[rr * 64 + cc] = GL[cc] * val + (rr == cc ? GL[rr] : 0.f); });
      mm16<4, 4>(tid, [&](f32x4* acc, const int* ii, const int* jj, int kq) { MMK(64, RB(0)[k * 68 + i], RB(6)[k * 68 + j]) MMK(64, RB(1)[k * 68 + i], RB(7)[k * 68 + j]) },
                 [&](int rr, int cc, float val) { Dt[rr * 64 + cc] = GL[cc] * val; });
      mm16<4, 4>(tid, [&](f32x4* acc, const int* ii, const int* jj, int kq) { MMK(64, RB(5)[i * 68 + k], RB(7)[j * 68 + k]) },
                 [&](int rr, int cc, float val) { RB(2)[rr * 68 + cc] = cc <= rr ? val : 0.f; });
      mm16<4, 4>(tid, [&](f32x4* acc, const int* ii, const int* jj, int kq) { MMK(64, RB(3)[i * 68 + k], RB(4)[k * 68 + j]) },
                 [&](int rr, int cc, float val) { store_bf16_at(Qt + rr * 64 + cc, RB(5)[rr * 68 + cc] + val); });
    }
    __syncthreads();
    bf16* XGb = reinterpret_cast<bf16*>(RB(4));
    bf16* GUt = reinterpret_cast<bf16*>(RB(0));
    {
      bf16* Yt = YIg + (size_t)task * 4096;
      const float* gsrc = gup + (size_t)(tid >> 4) * 512 + hc + (tid & 15) * 4;
      const float4 gu0 = *reinterpret_cast<const float4*>(gsrc);
      const float4 gu1 = *reinterpret_cast<const float4*>(gsrc + 32 * 512);
      const float4 gu2 = *reinterpret_cast<const float4*>(gsrc + 64 * 512);
      const float4 gu3 = *reinterpret_cast<const float4*>(gsrc + 96 * 512);
      const float4 gu4 = *reinterpret_cast<const float4*>(gsrc + 128 * 512);
      for (int e = tid; e < 1280; e += 512) {
        const int t = e / 20, c8 = (e % 20) * 8; float x[8];
        lerp8(U, tok0 + t, (c * 64 + t) > 0, 1664 + c8, mu, x);
        uint4 pk;
        pk.x = cvt_pk_bf16(sigmoidf_(x[0]), sigmoidf_(x[1])); pk.y = cvt_pk_bf16(sigmoidf_(x[2]), sigmoidf_(x[3]));
        pk.z = cvt_pk_bf16(sigmoidf_(x[4]), sigmoidf_(x[5])); pk.w = cvt_pk_bf16(sigmoidf_(x[6]), sigmoidf_(x[7]));
        *reinterpret_cast<uint4*>(XGb + t * 168 + c8) = pk;
      }
      mm16<4, 4>(tid, [&](f32x4* acc, const int* ii, const int* jj, int kq) { MMK(64, RB(3)[i * 68 + k], RB(0)[k * 68 + j]) MMK(64, RB(2)[i * 68 + k], RB(1)[k * 68 + j]) },
                 [&](int rr, int cc, float val) { store_bf16_at(Yt + rr * 64 + cc, val); });
      __syncthreads();
      {
        const int gk = tid >> 4, gj = (tid & 15) * 4;
        bf16* d = GUt + gj * 168 + gk;
        T4(d, 168, gu0, 0); T4(d, 168, gu1, 32); T4(d, 168, gu2, 64); T4(d, 168, gu3, 96); T4(d, 168, gu4, 128);
      }
    }
    __syncthreads();
    {
      bf16* Gt = GTg + (size_t)task * 4096;
      mmb<4, 4, 160>(tid, XGb, 168, GUt, 168, [&](int rr, int cc, float val) { store_bf16_at(Gt + rr * 64 + cc, val); });
    }
  }
}

__device__ __forceinline__ void ph_rwkv_b(KP P, int layer) {
  float* sm = reinterpret_cast<float*>(smem_raw);
  float* Qs = sm;
  float* Ss = sm + 4352;
  float* Ys = sm + 2 * 4352;
  const bf16* U = reinterpret_cast<const bf16*>(P->ws + OFF_U);
  const float* Sg = reinterpret_cast<const float*>(P->ws + OFF_RD);
  const bf16* YIg = reinterpret_cast<const bf16*>(P->ws + OFF_RYI);
  const bf16* QEg = reinterpret_cast<const bf16*>(P->ws + OFF_RQE);
  const bf16* GTg = reinterpret_cast<const bf16*>(P->ws + OFF_RGT);
  const float* BCg = reinterpret_cast<const float*>(P->ws + OFF_RBC);
  bf16* YRW = reinterpret_cast<bf16*>(P->ws + OFF_YRW);
  const float* mu = P->in[8] + (size_t)layer * 1824;
  const float* gn_g = P->in[17] + (size_t)layer * 512;
  const float* gn_b = P->in[18] + (size_t)layer * 512;
  PHASE_TID
  const int et = tid >> 3, en = (tid & 7) * 8;
  uint4 nq, nyi, ngt, nvc, nvp; float4 ns0, ns1; float nbc;
#define RWB_LOAD(T) do { const int c_ = (T) & 127, h_ = ((T) >> 7) & 7, b_ = (T) >> 10; \
    const size_t tk_ = (size_t)b_ * SEQ + c_ * 64 + et; const size_t o_ = (size_t)(T) * 4096 + et * 64 + en; \
    nq = *reinterpret_cast<const uint4*>(QEg + o_); nyi = *reinterpret_cast<const uint4*>(YIg + o_); ngt = *reinterpret_cast<const uint4*>(GTg + o_); \
    nvc = *reinterpret_cast<const uint4*>(U + tk_ * LDU + 1024 + h_ * 64 + en); \
    nvp = (c_ * 64 + et) > 0 ? *reinterpret_cast<const uint4*>(U + (tk_ - 1) * LDU + 1024 + h_ * 64 + en) : make_uint4(0, 0, 0, 0); \
    ns0 = *reinterpret_cast<const float4*>(Sg + o_); ns1 = *reinterpret_cast<const float4*>(Sg + o_ + 4); nbc = BCg[(size_t)(T) * 64 + et]; } while (0)
  if (bid < 4096) RWB_LOAD(bid);
  for (int task = bid; task < 4096; task += GRID) {
    const int c = task & 127, h = (task >> 7) & 7, b = task >> 10;
    const size_t tok0 = (size_t)b * SEQ + c * 64;
    const int hc = h * 64;
    float q8[8], yi[8], gt[8], v[8];
    {
      float vc[8], vp[8];
      unpack8(nq, q8); unpack8(nyi, yi); unpack8(ngt, gt); unpack8(nvc, vc); unpack8(nvp, vp);
      const float4 m0 = *reinterpret_cast<const float4*>(mu + 1024 + hc + en), m1 = *reinterpret_cast<const float4*>(mu + 1024 + hc + en + 4);
      const float mm[8] = {m0.x, m0.y, m0.z, m0.w, m1.x, m1.y, m1.z, m1.w};
#pragma unroll
      for (int j = 0; j < 8; ++j) v[j] = vc[j] + (vp[j] - vc[j]) * mm[j];
    }
    const float4 s0 = ns0, s1 = ns1;
    const float bc = nbc;
    if (task + GRID < 4096) RWB_LOAD(task + GRID);
    __syncthreads();
#pragma unroll
    for (int j = 0; j < 8; ++j) Qs[et * 68 + en + j] = q8[j];
    *reinterpret_cast<float4*>(Ss + et * 68 + en) = s0;
    *reinterpret_cast<float4*>(Ss + et * 68 + en + 4) = s1;
    __syncthreads();
    mm16<4, 4>(tid, [&](f32x4* acc, const int* ii, const int* jj, int kq) { MMK(64, Qs[i * 68 + k], Ss[j * 68 + k]) },
               [&](int rr, int cc, float val) { Ys[rr * 68 + cc] = val; });
    __syncthreads();
    {
      float y[8], s = 0.f;
#pragma unroll
      for (int j = 0; j < 8; ++j) { y[j] = Ys[et * 68 + en + j] + yi[j]; s += y[j]; }
      s += __shfl_xor(s, 1); s += __shfl_xor(s, 2); s += __shfl_xor(s, 4);
      const float mean = s * (1.f / 64.f);
      float s2 = 0.f;
#pragma unroll
      for (int j = 0; j < 8; ++j) { y[j] -= mean; s2 += y[j] * y[j]; }
      s2 += __shfl_xor(s2, 1); s2 += __shfl_xor(s2, 2); s2 += __shfl_xor(s2, 4);
      const float rstd = rsqrtf(s2 * (1.f / 64.f) + 64e-5f);
      float o[8];
#pragma unroll
      for (int j = 0; j < 8; ++j) {
        const int n = en + j;
        o[j] = (y[j] * rstd * gn_g[hc + n] + gn_b[hc + n] + bc * v[j]) * gt[j];
      }
      bf16* dst = YRW + (tok0 + et) * 512 + hc + en;
      store4bf(dst, o[0], o[1], o[2], o[3]); store4bf(dst + 4, o[4], o[5], o[6], o[7]);
    }
  }
}

__device__ __forceinline__ void ph_rwkv_scan(KP P, int layer) {
  float* Ss = reinterpret_cast<float*>(smem_raw);
  const float* Pg = reinterpret_cast<const float*>(P->ws + OFF_RP);
  float* Dg = reinterpret_cast<float*>(P->ws + OFF_RD);
  PHASE_TID
  const int wave = tid >> 6, lane = tid & 63, li = lane & 15, kq = lane >> 4;
  if (bid >= 128) {
    bf16* W = reinterpret_cast<bf16*>(P->ws + OFF_W);
    const size_t l = layer;
    const int cb = bid - 128;
    conv_mat(tid, cb, P->in[25] + l * DM * DFF, DFF, 0, DFF, DM, W + W_F2GU, 1, 128);
    conv_mat(tid, cb, P->in[26] + l * DM * DFF, DFF, 0, DFF, DM, W + W_F2GU, 2, 128);
    conv_mat(tid, cb, P->in[27] + l * DFF * DM, DM, 0, DM, DFF, W + W_F2D, 0, 128);
    if (layer < 3) {
      conv_mat(tid, cb, P->in[4] + (l + 1) * DM * DFF, DFF, 0, DFF, DM, W + W_F1GU, 1, 128);
      conv_mat(tid, cb, P->in[5] + (l + 1) * DM * DFF, DFF, 0, DFF, DM, W + W_F1GU, 2, 128);
      conv_mat(tid, cb, P->in[6] + (l + 1) * DFF * DM, DM, 0, DM, DFF, W + W_F1D, 0, 128);
    }
  }
  for (int task = bid; task < 128; task += GRID) {
    const int bh = task >> 2, rt = task & 3;
    __syncthreads();
    for (int e = tid; e < 16 * 68; e += 512) Ss[e] = 0.f;
    __syncthreads();
    if (wave < 4) {
      const int ct = wave;
      f32x4 sreg = {0.f, 0.f, 0.f, 0.f};
      float pn[16]; f32x4 dn;
      {
        const float* Pc = Pg + (size_t)(bh * 128) * 4096; const float* Dc = Dg + (size_t)(bh * 128) * 4096;
#pragma unroll
        for (int q = 0; q < 16; ++q) pn[q] = Pc[(q * 4 + kq) * 64 + ct * 16 + li];
#pragma unroll
        for (int r = 0; r < 4; ++r) dn[r] = Dc[(rt * 16 + kq * 4 + r) * 64 + ct * 16 + li];
      }
      for (int c = 0; c < 128; ++c) {
        float pc[16]; f32x4 acc0 = dn, acc1 = {0.f, 0.f, 0.f, 0.f};
#pragma unroll
        for (int q = 0; q < 16; ++q) pc[q] = pn[q];
        float* So = Dg + (size_t)(bh * 128 + c) * 4096;
#pragma unroll
        for (int r = 0; r < 4; ++r) So[(rt * 16 + kq * 4 + r) * 64 + ct * 16 + li] = sreg[r];
        if (c + 1 < 128) {
          const float* Pc = Pg + (size_t)(bh * 128 + c + 1) * 4096; const float* Dc = Dg + (size_t)(bh * 128 + c + 1) * 4096;
#pragma unroll
          for (int q = 0; q < 16; ++q) pn[q] = Pc[(q * 4 + kq) * 64 + ct * 16 + li];
#pragma unroll
          for (int r = 0; r < 4; ++r) dn[r] = Dc[(rt * 16 + kq * 4 + r) * 64 + ct * 16 + li];
        }
#pragma unroll
        for (int q = 0; q < 16; q += 2) {
          acc0 = __builtin_amdgcn_mfma_f32_16x16x4f32(Ss[li * 68 + q * 4 + kq], pc[q], acc0, 0, 0, 0);
          acc1 = __builtin_amdgcn_mfma_f32_16x16x4f32(Ss[li * 68 + (q + 1) * 4 + kq], pc[q + 1], acc1, 0, 0, 0);
        }
        sreg = acc0 + acc1;
        asm volatile("s_waitcnt lgkmcnt(0)" ::: "memory");
        __builtin_amdgcn_s_barrier();
#pragma unroll
        for (int r = 0; r < 4; ++r) Ss[(kq * 4 + r) * 68 + ct * 16 + li] = sreg[r];
        asm volatile("s_waitcnt lgkmcnt(0)" ::: "memory");
        __builtin_amdgcn_s_barrier();
      }
    } else {
      for (int c = 0; c < 128; ++c) { __builtin_amdgcn_s_barrier(); __builtin_amdgcn_s_barrier(); }
    }
  }
}

__device__ __forceinline__ void hg_lb_setup(const int tid, KP P, int layer, float* LB) {
  const float* raw = P->in[19];
  for (int ch = tid; ch < 512; ch += 512) {
    const float r0 = raw[ch], r1 = raw[512 + ch], r2 = raw[1024 + ch], r3 = raw[1536 + ch];
    const float mx = fmaxf(fmaxf(r0, r1), fmaxf(r2, r3));
    const float e0 = expf(r0 - mx), e1 = expf(r1 - mx), e2 = expf(r2 - mx), e3 = expf(r3 - mx);
    const float inv = 1.f / (e0 + e1 + e2 + e3);
    float lb = 0.f;
    if (layer >= 1) lb += e1 * inv;
    if (layer >= 2) lb += e2 * inv;
    if (layer >= 3) lb += e3 * inv;
    LB[ch] = lb;
  }
}
__device__ __forceinline__ void hg_fk(const float* x, const float* lb, float* lf, float* kk) {
#pragma unroll
  for (int j = 0; j < 8; ++j) {
    const float e = __expf(-fabsf(x[j]));
    const float rc = 1.f / (1.f + e);
    const float sp = x[j] >= 0.f ? rc : e * rc;
    const float sn = x[j] >= 0.f ? e * rc : rc;
    const float f = lb[j] + (1.f - lb[j]) * sp;
    lf[j] = __logf(f);
    kk[j] = (1.f - lb[j]) * sn;
  }
}
__device__ __forceinline__ void hg_cumsum(const int tid, float* G, float* ST, const float scale) {
  const int k = tid & 127, seg = tid >> 7;
  float run = 0.f;
#pragma unroll
  for (int t = 0; t < 16; ++t) { run += G[(seg * 16 + t) * 132 + k]; G[(seg * 16 + t) * 132 + k] = run; }
  ST[seg * 128 + k] = run;
  __syncthreads();
  float off = 0.f;
  if (seg > 0) off += ST[k];
  if (seg > 1) off += ST[128 + k];
  if (seg > 2) off += ST[256 + k];
#pragma unroll
  for (int t = 0; t < 16; ++t) { const int o = (seg * 16 + t) * 132 + k; G[o] = (G[o] + off) * scale; }
  __syncthreads();
}

__device__ __forceinline__ void ph_hg1(KP P, int layer) {
  float* G = reinterpret_cast<float*>(smem_raw);
  float* KK = G + 8448;
  bf16* KDt = reinterpret_cast<bf16*>(KK + 8448);
  bf16* Vt = KDt + 128 * 72;
  float* ST = reinterpret_cast<float*>(Vt + 128 * 72);
  float* LB = ST + 512;
  const bf16* U = reinterpret_cast<const bf16*>(P->ws + OFF_U);
  bf16* Dg = reinterpret_cast<bf16*>(P->ws + OFF_HD);
  float* Gg = reinterpret_cast<float*>(P->ws + OFF_HG);
  PHASE_TID
  __syncthreads();
  hg_lb_setup(tid, P, layer, LB);
  uint4 nf0, nf1, nv0, nv1;
#define HG1_LOAD(T) do { const int c_ = (T) & 127, h_ = ((T) >> 7) & 3, b_ = (T) >> 9; const size_t tk_ = (size_t)b_ * SEQ + c_ * 64; \
    nf0 = *reinterpret_cast<const uint4*>(U + (tk_ + (tid >> 4)) * LDU + 512 + h_ * 128 + (tid & 15) * 8); \
    nf1 = *reinterpret_cast<const uint4*>(U + (tk_ + 32 + (tid >> 4)) * LDU + 512 + h_ * 128 + (tid & 15) * 8); \
    nv0 = *reinterpret_cast<const uint4*>(U + (tk_ + (tid & 63)) * LDU + 1024 + h_ * 128 + (tid >> 6) * 8); \
    nv1 = *reinterpret_cast<const uint4*>(U + (tk_ + (tid & 63)) * LDU + 1024 + h_ * 128 + (8 + (tid >> 6)) * 8); } while (0)
  if (bid < 2048) HG1_LOAD(bid);
  for (int task = bid; task < 2048; task += GRID) {
    const int h = (task >> 7) & 3;
    const uint4 f0 = nf0, f1 = nf1, v0 = nv0, v1 = nv1;
    __syncthreads();
    if (task + GRID < 2048) HG1_LOAD(task + GRID);
    {
      float x[8], lf[8], kk[8];
      { const int t = tid >> 4, k8 = (tid & 15) * 8;
        unpack8(f0, x); hg_fk(x, LB + h * 128 + k8, lf, kk);
#pragma unroll
        for (int j = 0; j < 8; ++j) { G[t * 132 + k8 + j] = lf[j]; KK[t * 132 + k8 + j] = kk[j]; } }
      { const int t = 32 + (tid >> 4), k8 = (tid & 15) * 8;
        unpack8(f1, x); hg_fk(x, LB + h * 128 + k8, lf, kk);
#pragma unroll
        for (int j = 0; j < 8; ++j) { G[t * 132 + k8 + j] = lf[j]; KK[t * 132 + k8 + j] = kk[j]; } }
      scatter8(v0, reinterpret_cast<unsigned short*>(Vt) + ((tid >> 6) * 8) * 72 + (tid & 63), 72);
      scatter8(v1, reinterpret_cast<unsigned short*>(Vt) + ((8 + (tid >> 6)) * 8) * 72 + (tid & 63), 72);
    }
    __syncthreads();
    hg_cumsum(tid, G, ST, 1.f);
    if (tid < 128) Gg[(size_t)task * 128 + tid] = __expf(G[63 * 132 + tid]);
#pragma unroll 4
    for (int i = 0; i < 16; ++i) {
      const int e = tid + 512 * i, s = e & 63, k = e >> 6;
      KDt[k * 72 + s] = __float2bfloat16(KK[s * 132 + k] * __expf(G[63 * 132 + k] - G[s * 132 + k]));
    }
    __syncthreads();
    bf16* Dt = Dg + (size_t)task * 16384;
    mmb<8, 8, 64>(tid, Vt, 72, KDt, 72, [&](int r, int cc, float v) { Dt[r * 128 + cc] = __float2bfloat16(v); });
  }
}
__device__ __forceinline__ void ph_hg2(KP P) {
  const unsigned short* Dg = reinterpret_cast<const unsigned short*>(P->ws + OFF_HD);
  const float* Gg = reinterpret_cast<const float*>(P->ws + OFF_HG);
  bf16* Sg = reinterpret_cast<bf16*>(P->ws + OFF_HS);
  PHASE_TID
  for (int e = bid * 512 + tid; e < 16 * 16384; e += GRID * 512) {
    const int bh = e >> 14, vk = e & 16383, k = vk & 127;
    float S = 0.f;
#pragma unroll 16
    for (int c = 0; c < 128; ++c) {
      const size_t t = (size_t)bh * 128 + c;
      const float d = __uint_as_float((unsigned)Dg[t * 16384 + vk] << 16), g = Gg[t * 128 + k];
      Sg[t * 16384 + vk] = __float2bfloat16(S);
      S = g * S + d;
    }
  }
}
__device__ __forceinline__ void ph_hg3(KP P, int layer) {
  float* Q = reinterpret_cast<float*>(smem_raw);
  float* KK = Q + 8448;
  float* G2 = KK + 8448;
  bf16* Ab = reinterpret_cast<bf16*>(G2 + 8448);
  bf16* Vt = Ab + 64 * 72;
  bf16* QEb = Vt + 128 * 72;
  float* ST = reinterpret_cast<float*>(QEb + 64 * 136);
  float* LB = ST + 512;
  bf16* SINt = reinterpret_cast<bf16*>(KK);
  const bf16* U = reinterpret_cast<const bf16*>(P->ws + OFF_U);
  const bf16* Sg = reinterpret_cast<const bf16*>(P->ws + OFF_HS);
  bf16* YHG = reinterpret_cast<bf16*>(P->ws + OFF_YHG);
  const float* norm_g = P->in[20] + (size_t)layer * 512;
  PHASE_TID
  const int wave = tid >> 6, lane = tid & 63, li = lane & 15, kq = lane >> 4;
  __syncthreads();
  hg_lb_setup(tid, P, layer, LB);
  for (int task = bid; task < 2048; task += GRID) {
    const int c = task & 127, h = (task >> 7) & 3, b = task >> 9;
    const size_t tok0 = (size_t)b * SEQ + c * 64;
    __syncthreads();
#pragma unroll
    for (int i = 0; i < 2; ++i) {
      const int e = tid + 512 * i;
      { const int t = e >> 4, k8 = (e & 15) * 8;
        float x[8], lf[8], kk[8], q[8];
        load8(U + (tok0 + t) * LDU + 512 + h * 128 + k8, x);
        hg_fk(x, LB + h * 128 + k8, lf, kk);
        load8(U + (tok0 + t) * LDU + h * 128 + k8, q);
#pragma unroll
        for (int j = 0; j < 8; ++j) { const int o = t * 132 + k8 + j; G2[o] = lf[j]; KK[o] = kk[j]; Q[o] = sigmoidf_(q[j]); } }
    }
    const uint4 vr0 = *reinterpret_cast<const uint4*>(U + (tok0 + (tid & 63)) * LDU + 1024 + h * 128 + (tid >> 6) * 8);
    const uint4 vr1 = *reinterpret_cast<const uint4*>(U + (tok0 + (tid & 63)) * LDU + 1024 + h * 128 + ((tid + 512) >> 6) * 8);
    __syncthreads();
    hg_cumsum(tid, G2, ST, 1.4426950408889634f);
    bf16* X1 = QEb;
    bf16* X2 = Vt;
    for (int e = tid; e < 1536; e += 512) {
      const int blk = e >> 8, r = (e >> 4) & 15, cc = e & 15;
      const int bi = blk < 3 ? 0 : (blk < 5 ? 1 : 2), bj = blk < 3 ? blk + 1 : (blk < 5 ? blk - 1 : 3);
      Ab[(bi * 16 + r) * 72 + bj * 16 + cc] = __float2bfloat16(0.f);
    }
    for (int i = 0; i < 2; ++i) {
      const int t0 = (wave * 2 + i) * 4, t = t0 + (lane >> 4), s = (t0 & ~15) + (lane & 15);
      float a = 0.f;
      const float4* qt = reinterpret_cast<const float4*>(Q + t * 132);
      const float4* gt = reinterpret_cast<const float4*>(G2 + t * 132);
      const float4* ks = reinterpret_cast<const float4*>(KK + s * 132);
      const float4* gs = reinterpret_cast<const float4*>(G2 + s * 132);
#pragma unroll 4
      for (int k4 = 0; k4 < 32; ++k4) {
        const float4 q4 = qt[k4], g4 = gt[k4], k4v = ks[k4], h4 = gs[k4];
        a = fmaf(q4.x * k4v.x, exp2f(fminf(g4.x - h4.x, 0.f)), a);
        a = fmaf(q4.y * k4v.y, exp2f(fminf(g4.y - h4.y, 0.f)), a);
        a = fmaf(q4.z * k4v.z, exp2f(fminf(g4.z - h4.z, 0.f)), a);
        a = fmaf(q4.w * k4v.w, exp2f(fminf(g4.w - h4.w, 0.f)), a);
      }
      Ab[t * 72 + s] = __float2bfloat16(s <= t ? a : 0.f);
    }
#pragma unroll 2
    for (int i = 0; i < 8; ++i) {
      const int e = tid + 512 * i, t = e >> 6, k2 = (e & 63) * 2;
      const float g0 = G2[t * 132 + k2], g1 = G2[t * 132 + k2 + 1];
      {
        const float r0 = G2[31 * 132 + k2], r1 = G2[31 * 132 + k2 + 1];
        float x0, x1;
        if (t < 32) { x0 = KK[t * 132 + k2] * exp2f(fminf(r0 - g0, 0.f)); x1 = KK[t * 132 + k2 + 1] * exp2f(fminf(r1 - g1, 0.f)); }
        else { x0 = Q[t * 132 + k2] * exp2f(fminf(g0 - r0, 0.f)); x1 = Q[t * 132 + k2 + 1] * exp2f(fminf(g1 - r1, 0.f)); }
        *reinterpret_cast<unsigned*>(X1 + t * 136 + k2) = cvt_pk_bf16(x0, x1);
      }
      {
        const int rb = (t < 32) ? 15 : 47;
        const float r0 = G2[rb * 132 + k2], r1 = G2[rb * 132 + k2 + 1];
        float x0, x1;
        if ((t & 31) < 16) { x0 = KK[t * 132 + k2] * exp2f(fminf(r0 - g0, 0.f)); x1 = KK[t * 132 + k2 + 1] * exp2f(fminf(r1 - g1, 0.f)); }
        else { x0 = Q[t * 132 + k2] * exp2f(fminf(g0 - r0, 0.f)); x1 = Q[t * 132 + k2 + 1] * exp2f(fminf(g1 - r1, 0.f)); }
        *reinterpret_cast<unsigned*>(X2 + t * 136 + k2) = cvt_pk_bf16(x0, x1);
      }
    }
    __syncthreads();
    if (wave < 6) {
      const bf16* Xs = wave < 4 ? X1 : X2;
      const int arow = wave < 4 ? 32 + (wave >> 1) * 16 : (wave == 4 ? 16 : 48);
      const int brow = wave < 4 ? (wave & 1) * 16 : (wave == 4 ? 0 : 32);
      f32x4 acc = {0.f, 0.f, 0.f, 0.f};
      const bf16* ap = Xs + (arow + li) * 136 + kq * 8;
      const bf16* bp = Xs + (brow + li) * 136 + kq * 8;
#pragma unroll
      for (int kk = 0; kk < 128; kk += 32)
        acc = __builtin_amdgcn_mfma_f32_16x16x32_bf16(*reinterpret_cast<const bf16x8*>(ap + kk), *reinterpret_cast<const bf16x8*>(bp + kk), acc, 0, 0, 0);
#pragma unroll
      for (int r = 0; r < 4; ++r) Ab[(arow + kq * 4 + r) * 72 + brow + li] = __float2bfloat16(acc[r]);
    }
    __syncthreads();
#pragma unroll 4
    for (int i = 0; i < 8; ++i) {
      const int e = tid + 512 * i, t = e >> 6, k2 = (e & 63) * 2;
      const float q0 = Q[t * 132 + k2] * exp2f(G2[t * 132 + k2]), q1 = Q[t * 132 + k2 + 1] * exp2f(G2[t * 132 + k2 + 1]);
      *reinterpret_cast<unsigned*>(QEb + t * 136 + k2) = cvt_pk_bf16(q0, q1);
    }
    scatter8(vr0, reinterpret_cast<unsigned short*>(Vt) + ((tid >> 6) * 8) * 72 + (tid & 63), 72);
    scatter8(vr1, reinterpret_cast<unsigned short*>(Vt) + (((tid + 512) >> 6) * 8) * 72 + (tid & 63), 72);
    __syncthreads();
    { const bf16* St = Sg + (size_t)task * 16384;
#pragma unroll
      for (int i = 0; i < 4; ++i) {
        const int e = tid + 512 * i, r = e >> 4, c8 = (e & 15) * 8;
        *reinterpret_cast<uint4*>(SINt + r * 136 + c8) = *reinterpret_cast<const uint4*>(St + r * 128 + c8);
      } }
    __syncthreads();
    f32x4 o[4];
    const int rt = wave & 3, cb = (wave >> 2) * 64;
    {
#pragma unroll
      for (int cc = 0; cc < 4; ++cc) o[cc] = f32x4{0.f, 0.f, 0.f, 0.f};
      const bf16* ap = Ab + (rt * 16 + li) * 72 + kq * 8;
#pragma unroll
      for (int kk = 0; kk < 64; kk += 32) {
        const bf16x8 a = *reinterpret_cast<const bf16x8*>(ap + kk);
#pragma unroll
        for (int cc = 0; cc < 4; ++cc)
          o[cc] = __builtin_amdgcn_mfma_f32_16x16x32_bf16(a, *reinterpret_cast<const bf16x8*>(Vt + (cb + cc * 16 + li) * 72 + kq * 8 + kk), o[cc], 0, 0, 0);
      }
      const bf16* qp = QEb + (rt * 16 + li) * 136 + kq * 8;
#pragma unroll
      for (int kk = 0; kk < 128; kk += 32) {
        const bf16x8 a = *reinterpret_cast<const bf16x8*>(qp + kk);
#pragma unroll
        for (int cc = 0; cc < 4; ++cc)
          o[cc] = __builtin_amdgcn_mfma_f32_16x16x32_bf16(a, *reinterpret_cast<const bf16x8*>(SINt + (cb + cc * 16 + li) * 136 + kq * 8 + kk), o[cc], 0, 0, 0);
      }
    }
#pragma unroll
    for (int cc = 0; cc < 4; ++cc)
#pragma unroll
      for (int r = 0; r < 4; ++r) Q[(rt * 16 + kq * 4 + r) * 132 + cb + cc * 16 + li] = o[cc][r];
    __syncthreads();
    {
      const int t = tid >> 3, v0 = (tid & 7) * 16;
      float y[16], ss = 0.f;
#pragma unroll
      for (int j = 0; j < 16; ++j) { y[j] = Q[t * 132 + v0 + j]; ss += y[j] * y[j]; }
      ss += __shfl_xor(ss, 1); ss += __shfl_xor(ss, 2); ss += __shfl_xor(ss, 4);
      const float sc = rsqrtf(ss * (1.f / 128.f) + 1e-5f);
      float og[16];
      load8(U + (tok0 + t) * LDU + 1536 + h * 128 + v0, og);
      load8(U + (tok0 + t) * LDU + 1536 + h * 128 + v0 + 8, og + 8);
      float r[16];
#pragma unroll
      for (int j = 0; j < 16; ++j) r[j] = y[j] * sc * norm_g[h * 128 + v0 + j] * (og[j] * sigmoidf_(og[j]));
      bf16* dst = YHG + (tok0 + t) * 512 + h * 128 + v0;
      store4bf(dst, r[0], r[1], r[2], r[3]); store4bf(dst + 4, r[4], r[5], r[6], r[7]);
      store4bf(dst + 8, r[8], r[9], r[10], r[11]); store4bf(dst + 12, r[12], r[13], r[14], r[15]);
    }
  }
}

#define KPL ({ KP q_ = kp0; asm volatile("" : "+s"(q_)); q_; })
#define WS_(T, off) reinterpret_cast<T*>(kp->ws + (off))
#define GSYNC() do { KP kpb_ = KPL; xcd_barrier(kpb_); } while (0)
__device__ __forceinline__ void layer_body(const KP kp0, const int layer_) {
  {
    int layer = layer_;
    asm volatile("" : "+s"(layer));
    { KP kp = KPL; ph_convert(kp, layer, layer == 0); }
    if (layer_ == 0) GSYNC(); else __syncthreads();
    { KP kp = KPL; ph_ffn_a(WS_(bf16, OFF_H16), WS_(bf16, OFF_W) + W_F1GU, WS_(bf16, OFF_ACT)); }
    GSYNC();
    { KP kp = KPL; if (layer_ == 0) ph_res<false>(WS_(bf16, OFF_ACT), WS_(bf16, OFF_W) + W_F1D, DFF, WS_(float, OFF_H32), 0.5f, WS_(float2, OFF_STATS), kp->in[2], kp->in[3], kp->in[0]); else ph_res<true>(WS_(bf16, OFF_ACT), WS_(bf16, OFF_W) + W_F1D, DFF, WS_(float, OFF_H32), 0.5f, WS_(float2, OFF_STATS), kp->in[2] + (size_t)(layer * 4 - 1) * DM, kp->in[3] + (size_t)(layer * 4 - 1) * DM); }
    GSYNC();
    { KP kp = KPL; ph_ln(WS_(float, OFF_H32), WS_(bf16, OFF_H16), kp->in[2] + (size_t)layer * 4 * DM, kp->in[3] + (size_t)layer * 4 * DM, nullptr, WS_(float2, OFF_STATS)); }
    GSYNC();
    { KP kp = KPL; ph_proj<false>(WS_(bf16, OFF_H16), WS_(bf16, OFF_W) + W_SB, 1536, DM, WS_(bf16, OFF_U), LDU); }
    GSYNC();
    { KP kp = KPL; ph_sb(WS_(bf16, OFF_U), WS_(bf16, OFF_YSB)); }
    GSYNC();
    { KP kp = KPL; ph_proj<false>(WS_(bf16, OFF_H16), WS_(bf16, OFF_W) + W_RW, 2048, DM, WS_(bf16, OFF_U), LDU); }
    GSYNC();
    { KP kp = KPL; ph_rwkv_a(kp, layer); }
    GSYNC();
    { KP kp = KPL; ph_rwkv_scan(kp, layer); }
    GSYNC();
    { KP kp = KPL; ph_rwkv_b(kp, layer); }
    GSYNC();
    { KP kp = KPL; ph_proj<false>(WS_(bf16, OFF_H16), WS_(bf16, OFF_W) + W_HG, 2048, DM, WS_(bf16, OFF_U), LDU); }
    GSYNC();
    { KP kp = KPL; ph_hg1(kp, layer); }
    GSYNC();
    { KP kp = KPL; ph_hg2(kp); }
    GSYNC();
    { KP kp = KPL; ph_hg3(kp, layer); }
    GSYNC();
    { KP kp = KPL; ph_proj<true>(WS_(bf16, OFF_H16), WS_(bf16, OFF_W) + W_GATE, 3072, DM, WS_(bf16, OFF_GATE), 3072); }
    GSYNC();
    { KP kp = KPL; ph_merge(WS_(bf16, OFF_YRW), WS_(bf16, OFF_YSB), WS_(bf16, OFF_YHG), WS_(bf16, OFF_W) + W_BR, WS_(bf16, OFF_GATE), WS_(float, OFF_M32), WS_(bf16, OFF_H16)); }
    GSYNC();
    { KP kp = KPL; ph_res<true>(WS_(bf16, OFF_H16), WS_(bf16, OFF_W) + W_OUT, DM, WS_(float, OFF_H32), 1.0f, WS_(float2, OFF_STATS), kp->in[2] + (size_t)(layer * 4) * DM, kp->in[3] + (size_t)(layer * 4) * DM); }
    GSYNC();
    { KP kp = KPL; ph_ln(WS_(float, OFF_H32), WS_(bf16, OFF_H16), kp->in[2] + (size_t)(layer * 4 + 1) * DM, kp->in[3] + (size_t)(layer * 4 + 1) * DM, nullptr, WS_(float2, OFF_STATS)); }
    GSYNC();
    { KP kp = KPL; ph_ffn_a(WS_(bf16, OFF_H16), WS_(bf16, OFF_W) + W_F2GU, WS_(bf16, OFF_ACT)); }
    GSYNC();
    { KP kp = KPL; ph_res<true>(WS_(bf16, OFF_ACT), WS_(bf16, OFF_W) + W_F2D, DFF, WS_(float, OFF_H32), 0.5f, WS_(float2, OFF_STATS), kp->in[2] + (size_t)(layer * 4 + 1) * DM, kp->in[3] + (size_t)(layer * 4 + 1) * DM); }
    GSYNC();
    { KP kp = KPL; ph_ln(WS_(float, OFF_H32), WS_(bf16, OFF_H16), kp->in[2] + (size_t)(layer * 4 + 2) * DM, kp->in[3] + (size_t)(layer * 4 + 2) * DM, nullptr, WS_(float2, OFF_STATS)); ph_pconv(kp, layer); }
    GSYNC();
    { KP kp = KPL; ph_ple(WS_(bf16, OFF_H16), WS_(bf16, OFF_P16), WS_(bf16, OFF_W) + W_PG, WS_(bf16, OFF_W) + W_PP, WS_(float, OFF_M32), WS_(float, OFF_H32), WS_(float2, OFF_STATS), kp->in[2] + (size_t)(layer * 4 + 2) * DM, kp->in[3] + (size_t)(layer * 4 + 2) * DM); }
    GSYNC();
    { KP kp = KPL; ph_ln(WS_(float, OFF_H32), WS_(bf16, OFF_H16), kp->in[2] + (size_t)(layer * 4 + 3) * DM, kp->in[3] + (size_t)(layer * 4 + 3) * DM, layer == 3 ? kp->out : nullptr, WS_(float2, OFF_STATS)); }
    if (layer_ < 3) GSYNC();
  }
}
__global__ void __launch_bounds__(512) fwd_megakernel(Params Pval) {
  const KP kp0 = (KP)__builtin_amdgcn_kernarg_segment_ptr();
  {
    cg::grid_group grid = cg::this_grid();
    unsigned* bar = reinterpret_cast<unsigned*>(kp0->ws + OFF_BAR);
    if (blockIdx.x == 0) for (int i = threadIdx.x; i < XCD_BAR_WORDS; i += 512) __hip_atomic_store(&bar[i], 0u, __ATOMIC_RELAXED, __HIP_MEMORY_SCOPE_AGENT);
    if (threadIdx.x == 0) {
      volatile unsigned* st = reinterpret_cast<volatile unsigned*>(smem_raw + XB_LDS_OFF);
      st[0] = 0u; st[1] = 0u; st[2] = 0u; st[3] = 0u;
    }
    grid.sync();
    if (threadIdx.x == 0) (void)xb_add(&bar[XB_XCNT(xb_xcc_id())], 1u);
    __syncthreads();
  }
  layer_body(kp0, 0);
  layer_body(kp0, 1);
  layer_body(kp0, 2);
  layer_body(kp0, 3);
}

extern "C" void kernel_launch(void* const* d_in, const int* in_sizes, int n_in, void* d_out, int out_size, void* d_ws,
                              size_t ws_size, hipStream_t stream) {
  static int inited = 0;
  if (!inited) {
    (void)hipFuncSetAttribute((const void*)fwd_megakernel, hipFuncAttributeMaxDynamicSharedMemorySize, LDS_BYTES);
    inited = 1;
  }
  Params p{};
  for (int i = 0; i < 30; ++i) p.in[i] = (const float*)d_in[i];
  p.out = (float*)d_out;
  p.ws = (unsigned char*)d_ws;
  void* args[] = {&p};
  hipError_t e = hipLaunchCooperativeKernel((const void*)fwd_megakernel, dim3(256), dim3(512), args, LDS_BYTES, stream);
  if (e != hipSuccess) fprintf(stderr, "cooperative launch failed: %s\n", hipGetErrorString(e));
}
```
